# Optimizing an MI355X kernel written in HIP

```python
import jax, jax.numpy as jnp
from jax import lax
import numpy as np

D_MODEL = 2048
BATCH = 4
SEQ = 2048
DEPTH = 2

POOL_WIDTH = D_MODEL // 2
POOL_GROUPS = 4
POOL_GROUP_DIM = POOL_WIDTH // POOL_GROUPS
POOL_WINDOWS = (2, 4, 8, 16)
RWKV_WIDTH = D_MODEL // 2
RWKV_HEAD_DIM = 64
RWKV_HEADS = RWKV_WIDTH // RWKV_HEAD_DIM
DECAY_LORA = 64
AAA_LORA = 64
MV_LORA = 32
RMS_EPS = 1e-6
LNX_EPS = 64e-5
N_SHIFT_COLS = 4 * RWKV_WIDTH + DECAY_LORA + AAA_LORA
N_IN = 2 * POOL_WIDTH + N_SHIFT_COLS + 2 * D_MODEL

kernel_name = "hybrid_pool_rwkv7_adaln_sandwich"


def rmsnorm(x, g):
    xf = x.astype(jnp.float32)
    y = xf * lax.rsqrt(jnp.mean(xf * xf, axis=-1, keepdims=True) + RMS_EPS)
    return (y * g).astype(x.dtype)


def token_shift(z, mu):
    prev = jnp.pad(z, ((0, 0), (1, 0), (0, 0)))[:, :-1]
    return z + (prev - z) * mu


def causal_multiscale_pool(u):
    b, s, _ = u.shape
    ug = u.astype(jnp.float32).reshape(b, s, POOL_GROUPS, POOL_GROUP_DIM)
    cs = jnp.pad(jnp.cumsum(ug, axis=1), ((0, 0), (1, 0), (0, 0), (0, 0)))
    hi = jnp.arange(1, s + 1)
    outs = []
    for g, w in enumerate(POOL_WINDOWS):
        lo = jnp.maximum(hi - w, 0)
        cnt = (hi - lo).astype(jnp.float32)[None, :, None]
        mean = (cs[:, hi, g] - cs[:, lo, g]) / cnt
        outs.append(mean - ug[:, :, g])
    return jnp.stack(outs, axis=2).astype(u.dtype)


def wkv7(r, decay, k, v, a, b):
    bsz, _, h, n = r.shape

    def step(state, inp):
        r_t, w_t, k_t, v_t, a_t, b_t = inp
        sa = jnp.einsum('bhvk,bhk->bhv', state, a_t)
        state = (state * w_t[:, :, None, :] + sa[..., None] * b_t[:, :, None, :]
                 + v_t[..., None] * k_t[:, :, None, :])
        y = jnp.einsum('bhvk,bhk->bhv', state, r_t)
        return state, y

    xs = tuple(jnp.moveaxis(t.astype(jnp.float32), 1, 0) for t in (r, decay, k, v, a, b))
    s0 = jnp.zeros((bsz, h, n, n), jnp.float32)
    _, y = lax.scan(step, s0, xs)
    return jnp.moveaxis(y, 0, 1)


def setup_inputs(seed: int = 0) -> dict:
    key = jax.random.key(seed)
    ks = jax.random.split(key, 32)
    f32 = jnp.float32
    nrm = lambda k, shape, s: jax.random.normal(k, shape, f32) * s
    L, Lm = DEPTH, DEPTH - 1
    H, N = RWKV_HEADS, RWKV_HEAD_DIM
    return {
        "x": nrm(ks[0], (BATCH, SEQ, D_MODEL), 1.0),
        "c": nrm(ks[1], (BATCH, D_MODEL), 1.0),
        "w_ada": nrm(ks[2], (L, D_MODEL, 3 * D_MODEL), D_MODEL ** -0.5),
        "b_ada": nrm(ks[3], (L, 3 * D_MODEL), 0.02),
        "g_pre": 1.0 + nrm(ks[4], (L, D_MODEL), 0.05),
        "w_in": nrm(ks[5], (L, D_MODEL, N_IN), D_MODEL ** -0.5),
        "w_pool": nrm(ks[6], (L, POOL_GROUPS, POOL_GROUP_DIM, POOL_GROUP_DIM), POOL_GROUP_DIM ** -0.5),
        "pool_scale": jax.random.uniform(ks[7], (L, POOL_WIDTH), f32, 0.5, 1.5),
        "mu_shift": jax.random.uniform(ks[8], (L, N_SHIFT_COLS), f32, 0.0, 1.0),
        "w_decay_up": nrm(ks[9], (L, DECAY_LORA, RWKV_WIDTH), DECAY_LORA ** -0.5),
        "w0": jax.random.uniform(ks[10], (L, RWKV_WIDTH), f32, -3.0, 1.0),
        "w_aaa_up": nrm(ks[11], (L, AAA_LORA, RWKV_WIDTH), AAA_LORA ** -0.5),
        "a0": nrm(ks[12], (L, RWKV_WIDTH), 0.5),
        "w_mv_down": nrm(ks[13], (Lm, D_MODEL, MV_LORA), D_MODEL ** -0.5),
        "mu_mv": jax.random.uniform(ks[14], (Lm, MV_LORA), f32, 0.0, 1.0),
        "w_mv_up": nrm(ks[15], (Lm, MV_LORA, RWKV_WIDTH), MV_LORA ** -0.5),
        "mv0": nrm(ks[16], (Lm, RWKV_WIDTH), 0.5),
        "k_k": 0.85 + nrm(ks[17], (L, RWKV_WIDTH), 0.05),
        "k_a": 1.0 + nrm(ks[18], (L, RWKV_WIDTH), 0.05),
        "r_k": nrm(ks[19], (L, H, N), 0.1),
        "lnx_g": 1.0 + nrm(ks[20], (L, RWKV_WIDTH), 0.05),
        "lnx_b": nrm(ks[21], (L, RWKV_WIDTH), 0.02),
        "w_br_a": nrm(ks[22], (L, POOL_WIDTH, D_MODEL), POOL_WIDTH ** -0.5),
        "w_br_b": nrm(ks[23], (L, RWKV_WIDTH, D_MODEL), RWKV_WIDTH ** -0.5),
        "w_out": nrm(ks[24], (L, D_MODEL, D_MODEL), D_MODEL ** -0.5),
        "g_post": 1.0 + nrm(ks[25], (L, D_MODEL), 0.05),
    }


def reference(x, c, w_ada, b_ada, g_pre, w_in, w_pool, pool_scale, mu_shift,
              w_decay_up, w0, w_aaa_up, a0, w_mv_down, mu_mv, w_mv_up, mv0,
              k_k, k_a, r_k, lnx_g, lnx_b, w_br_a, w_br_b, w_out, g_post):
    bsz, s, _ = x.shape
    H, N = RWKV_HEADS, RWKV_HEAD_DIM
    cond = jax.nn.silu(c)
    split_in = [POOL_WIDTH, 2 * POOL_WIDTH, 2 * POOL_WIDTH + N_SHIFT_COLS,
                2 * POOL_WIDTH + N_SHIFT_COLS + D_MODEL]
    split_shift = [RWKV_WIDTH, 2 * RWKV_WIDTH, 3 * RWKV_WIDTH, 4 * RWKV_WIDTH,
                   4 * RWKV_WIDTH + DECAY_LORA]
    v_first = None
    for l in range(DEPTH):
        mod = cond @ w_ada[l] + b_ada[l]
        shift, scale, gate = jnp.split(mod, 3, axis=-1)
        h = rmsnorm(x, g_pre[l]) * (1.0 + scale[:, None]) + shift[:, None]

        proj = h @ w_in[l]
        u_a, z_a, shifted, gate_a, gate_b = jnp.split(proj, split_in, axis=-1)

        pooled = causal_multiscale_pool(u_a)
        y_a = jnp.einsum('bsgc,gcd->bsgd', pooled, w_pool[l]).reshape(bsz, s, POOL_WIDTH)
        y_a = y_a * pool_scale[l] * jax.nn.silu(z_a)

        xs = token_shift(shifted, mu_shift[l])
        r, k, v, z_b, w_lo, a_lo = jnp.split(xs, split_shift, axis=-1)
        w_log = -jax.nn.softplus(-(w0[l] + jnp.tanh(w_lo.astype(jnp.float32)) @ w_decay_up[l])) - 0.5
        decay = jnp.exp(-jnp.exp(w_log))
        a = jax.nn.sigmoid(a0[l] + a_lo @ w_aaa_up[l])
        if l == 0:
            v_first = v
        else:
            mv = token_shift(h @ w_mv_down[l - 1], mu_mv[l - 1])
            v = v + (v_first - v) * jax.nn.sigmoid(mv0[l - 1] + mv @ w_mv_up[l - 1])
        kk = (k * k_k[l]).reshape(bsz, s, H, N).astype(jnp.float32)
        kk = kk / jnp.maximum(jnp.linalg.norm(kk, axis=-1, keepdims=True), 1e-12)
        k = k * (1.0 + (a - 1.0) * k_a[l])
        rh, kh, vh, ah = (t.reshape(bsz, s, H, N) for t in (r, k, v, a))
        dh = decay.reshape(bsz, s, H, N)
        o = wkv7(rh, dh, kh, vh, -kk, kk * ah)
        mu_o = jnp.mean(o, axis=-1, keepdims=True)
        var_o = jnp.mean(jnp.square(o - mu_o), axis=-1, keepdims=True)
        o = ((o - mu_o) * lax.rsqrt(var_o + LNX_EPS)).reshape(bsz, s, RWKV_WIDTH)
        o = (o * lnx_g[l] + lnx_b[l]).astype(v.dtype)
        bonus = jnp.sum(rh * kh * r_k[l], axis=-1, keepdims=True) * vh
        y_b = (o + bonus.reshape(bsz, s, RWKV_WIDTH)) * jax.nn.silu(z_b)

        merged = (jax.nn.sigmoid(gate_a) * (y_a @ w_br_a[l])
                  + jax.nn.sigmoid(gate_b) * (y_b @ w_br_b[l]))
        out = merged @ w_out[l]

        x = x + gate[:, None] * rmsnorm(out, g_post[l])
    return x
```

```cpp
#include <hip/hip_runtime.h>
#include <hip/hip_cooperative_groups.h>
#include <cstdio>
#include <cstdint>
namespace cg = cooperative_groups;

#ifndef MK_COOP
#define MK_COOP 1
#endif

#ifndef REPMASK
#define REPMASK 0
#endif
#define NREP(i) (1 + ((REPMASK >> (i)) & 1))
#define LAS __attribute__((address_space(3)))
typedef unsigned short bf16_t;
typedef short bf16x8 __attribute__((ext_vector_type(8)));
typedef float f32x4 __attribute__((ext_vector_type(4)));
typedef float f32x2 __attribute__((ext_vector_type(2)));
typedef unsigned u32x4 __attribute__((ext_vector_type(4)));
typedef unsigned u32x2 __attribute__((ext_vector_type(2)));

#define LDS_WAIT() asm volatile("s_waitcnt lgkmcnt(0)" ::: "memory")

__device__ __forceinline__ unsigned f2bf(float f) { unsigned u = __builtin_bit_cast(unsigned, f); return (u + 0x7fffu + ((u >> 16) & 1u)) >> 16; }
__device__ __forceinline__ unsigned pk2(float lo, float hi) { return f2bf(lo) | (f2bf(hi) << 16); }
typedef __bf16 bf16x2_t __attribute__((ext_vector_type(2)));
__device__ __forceinline__ unsigned cvtpk(float lo, float hi) { const f32x2 v = {lo, hi}; const bf16x2_t b = __builtin_convertvector(v, bf16x2_t); return __builtin_bit_cast(unsigned, b); }
__device__ __forceinline__ float bflo(unsigned u) { return __builtin_bit_cast(float, u << 16); }
__device__ __forceinline__ float bfhi(unsigned u) { return __builtin_bit_cast(float, u & 0xffff0000u); }
__device__ __forceinline__ float sigm(float x) { return __builtin_amdgcn_rcpf(1.f + __expf(-x)); }
__device__ __forceinline__ float silu(float x) { return x * __builtin_amdgcn_rcpf(1.f + __expf(-x)); }
__device__ __forceinline__ float tanh_(float x) { return 1.f - 2.f * __builtin_amdgcn_rcpf(__expf(2.f * x) + 1.f); }
__device__ __forceinline__ float softplus_(float x) { return fmaxf(x, 0.f) + __logf(1.f + __expf(-fabsf(x))); }

constexpr int DM = 2048, NBATCH = 4, SEQ = 2048, M = NBATCH * SEQ;
constexpr int PW = 1024, RW = 1024, NH = 16, HD = 64;
constexpr int NIN = 10368, NPAD = 10496;
constexpr int C_ZA = 1024, C_R = 2048, C_K = 3072, C_V = 4096, C_ZB = 5120, C_WLO = 6144, C_ALO = 6208, C_GA = 6272, C_GB = 8320, C_MV = 10368;
constexpr float RMS_EPS = 1e-6f, LNX_EPS = 64e-5f;

namespace pg8 {
constexpr int BM = 256, BK = 64, HALF = 128, HTB = HALF * BK * 2, NXCD = 8, WGM = 8;
__host__ __device__ __forceinline__ int lds_byte(int r, int c) { const int st = (r >> 4) * 2 + (c >> 5), rr = r & 15, cc = c & 31, ob = rr * 64 + cc * 2; return st * 1024 + (ob ^ (((ob >> 9) & 1) << 5)); }
__host__ __device__ __forceinline__ void stage_rc(int b, int& R, int& C) { const int st = b / 1024, sb = b % 1024, swz = sb ^ (((sb >> 9) & 1) << 5); R = (st >> 1) * 16 + swz / 64; C = (st & 1) * 32 + (swz % 64) / 2; }
__host__ __device__ __forceinline__ int perm32(int rho) { const int n = rho >> 4, i = rho & 15; return 8 * (i >> 2) + 4 * n + (i & 3); }

struct Unit { int pm, pn; };
struct Gemm { const bf16_t* A; const bf16_t* Bt; int M, N, K; };

struct StaticOrder {
    int nM, nN, nwg, G, c;
    __device__ void init(int M_, int N_, int G_, int c_) { nM = M_ / BM; nN = N_ / BM; nwg = nM * nN; G = G_; c = c_; }
    __device__ bool next(int i, Unit& u) const {
        const long L = (long)i * G + c; if (L >= nwg) return false;
        int wgid = (int)L; { const int q = nwg / NXCD, r = nwg % NXCD, xcd = wgid % NXCD, off = wgid / NXCD; wgid = (xcd < r ? xcd * (q + 1) : r * (q + 1) + (xcd - r) * q) + off; }
        const int nig = WGM * nN, gid = wgid / nig, fm = gid * WGM, gsz = (nM - fm) < WGM ? (nM - fm) : WGM;
        u.pm = fm + ((wgid % nig) % gsz); u.pn = (wgid % nig) / gsz; return true;
    }
    __device__ __forceinline__ void a_ready(const Unit&) const {}
    __device__ __forceinline__ void done(const Unit&) const {}
};
struct OneUnit {
    bool valid; Unit u;
    __device__ bool next(int i, Unit& o) const { if (i != 0 || !valid) return false; o = u; return true; }
    __device__ __forceinline__ void a_ready(const Unit&) const {}
    __device__ __forceinline__ void done(const Unit&) const {}
};

__device__ __forceinline__ unsigned cvt_pk_bf16(float lo, float hi) { unsigned r; asm volatile("v_cvt_pk_bf16_f32 %0, %1, %2" : "=v"(r) : "v"(lo), "v"(hi)); return r; }

struct EpiBf16 {
    static constexpr bool PERM = true, AFTER_DRAIN = false;
    bf16_t* O; int ldc;
    __device__ __forceinline__ void operator()(const f32x4 (&acc)[2][2][4][2], const Unit& u, int wr, int wc, int fr, int fq) const {
        const int row0 = u.pm * BM + wr * 64 + fr, col0 = u.pn * BM + wc * 32 + 8 * fq;
#pragma unroll
        for (int ai = 0; ai < 2; ++ai)
#pragma unroll
            for (int m = 0; m < 4; ++m) { bf16_t* rowp = O + (size_t)(row0 + ai * HALF + m * 16) * ldc + col0;
#pragma unroll
                for (int bj = 0; bj < 2; ++bj) { const f32x4 v0 = acc[ai][bj][m][0], v1 = acc[ai][bj][m][1];
                    u32x4 w; w.x = cvt_pk_bf16(v0[0], v0[1]); w.y = cvt_pk_bf16(v0[2], v0[3]); w.z = cvt_pk_bf16(v1[0], v1[1]); w.w = cvt_pk_bf16(v1[2], v1[3]);
                    *(u32x4*)(rowp + bj * HALF) = w; } }
    }
};
template <bool ACCUM> struct EpiGate {
    static constexpr bool PERM = true, AFTER_DRAIN = false;
    bf16_t* O; int ldc; const bf16_t* G; int ldg; int gcol;
    __device__ __forceinline__ void operator()(const f32x4 (&acc)[2][2][4][2], const Unit& u, int wr, int wc, int fr, int fq) const {
        const int row0 = u.pm * BM + wr * 64 + fr, col0 = u.pn * BM + wc * 32 + 8 * fq;
#pragma unroll
        for (int ai = 0; ai < 2; ++ai)
#pragma unroll
            for (int m = 0; m < 4; m += 2) {
                u32x4 g[2][2], p[2][2];
#pragma unroll
                for (int mm = 0; mm < 2; ++mm) { const int row = row0 + ai * HALF + (m + mm) * 16; const bf16_t* gp = G + (size_t)row * ldg + gcol + col0; const bf16_t* rowp = O + (size_t)row * ldc + col0;
#pragma unroll
                    for (int bj = 0; bj < 2; ++bj) { g[mm][bj] = *(const u32x4*)(gp + bj * HALF); if (ACCUM) p[mm][bj] = *(const u32x4*)(rowp + bj * HALF); } }
#pragma unroll
                for (int mm = 0; mm < 2; ++mm) { const int row = row0 + ai * HALF + (m + mm) * 16; bf16_t* rowp = O + (size_t)row * ldc + col0;
#pragma unroll
                    for (int bj = 0; bj < 2; ++bj) { const f32x4 v0 = acc[ai][bj][m + mm][0], v1 = acc[ai][bj][m + mm][1]; const u32x4 gg = g[mm][bj];
                        float o[8];
                        o[0] = sigm(bflo(gg.x)) * v0[0]; o[1] = sigm(bfhi(gg.x)) * v0[1]; o[2] = sigm(bflo(gg.y)) * v0[2]; o[3] = sigm(bfhi(gg.y)) * v0[3];
                        o[4] = sigm(bflo(gg.z)) * v1[0]; o[5] = sigm(bfhi(gg.z)) * v1[1]; o[6] = sigm(bflo(gg.w)) * v1[2]; o[7] = sigm(bfhi(gg.w)) * v1[3];
                        if (ACCUM) { const u32x4 pp = p[mm][bj];
                            o[0] += bflo(pp.x); o[1] += bfhi(pp.x); o[2] += bflo(pp.y); o[3] += bfhi(pp.y); o[4] += bflo(pp.z); o[5] += bfhi(pp.z); o[6] += bflo(pp.w); o[7] += bfhi(pp.w); }
                        u32x4 w; w.x = cvt_pk_bf16(o[0], o[1]); w.y = cvt_pk_bf16(o[2], o[3]); w.z = cvt_pk_bf16(o[4], o[5]); w.w = cvt_pk_bf16(o[6], o[7]);
                        *(u32x4*)(rowp + bj * HALF) = w; } }
            }
    }
};
struct EpiF32 {
    static constexpr bool PERM = true, AFTER_DRAIN = false;
    float* O; int ldc;
    __device__ __forceinline__ void operator()(const f32x4 (&acc)[2][2][4][2], const Unit& u, int wr, int wc, int fr, int fq) const {
        const int row0 = u.pm * BM + wr * 64 + fr, col0 = u.pn * BM + wc * 32 + 8 * fq;
#pragma unroll
        for (int ai = 0; ai < 2; ++ai)
#pragma unroll
            for (int m = 0; m < 4; ++m) { float* rowp = O + (size_t)(row0 + ai * HALF + m * 16) * ldc + col0;
#pragma unroll
                for (int bj = 0; bj < 2; ++bj) { *(f32x4*)(rowp + bj * HALF) = acc[ai][bj][m][0]; *(f32x4*)(rowp + bj * HALF + 4) = acc[ai][bj][m][1]; } }
    }
};

template <class Epi, class Sched, bool ALIGN_EPI = false, bool SP2 = false>
__device__ __forceinline__ void gemm_phase(LAS unsigned char* lds, const Gemm g, const Sched& S, const Epi& E) {
    int tid_ = threadIdx.x; asm volatile("" : "+v"(tid_));
    const int tid = tid_, wid = __builtin_amdgcn_readfirstlane(tid >> 6), lane = tid & 63, wr = wid >> 2, wc = wid & 3, fr = lane & 15, fq = lane >> 4;
    const int K = g.K, nt = K / BK;
    unsigned voffA[2], voffB[2];
#pragma unroll
    for (int i = 0; i < 2; ++i) { int R, C; stage_rc(tid * 16 + i * 8192, R, C); const int Rb = Epi::PERM ? ((R & ~31) + perm32(R & 31)) : R;
        voffA[i] = (unsigned)(R * K + C) * 2u; voffB[i] = (unsigned)(Rb * K + C) * 2u; }
    const size_t kstep = (size_t)(BK * 2);
    const size_t hstep = (size_t)HALF * K * 2;
    const size_t tstep = 2 * hstep;
    const unsigned ldsw = (unsigned)wid * 1024u;
    const int aoff = lds_byte(wr * 64 + fr, fq * 8), boff = lds_byte(wc * 32 + fr, fq * 8);
#define PG8_SA(b, h) (((b) * 2 + (h)) * HTB)
#define PG8_SB(b, h) ((4 + (b) * 2 + (h)) * HTB)
#define PG8_STAGE(bufoff, gbase, voff) do { _Pragma("unroll") for (int _i = 0; _i < 2; ++_i) \
        __builtin_amdgcn_global_load_lds((const unsigned*)((const char*)(gbase) + (voff)[_i]), (LAS unsigned*)(lds + (bufoff) + ldsw + _i * 8192), 16, 0, 0); } while (0)
#define PG8_LDA(dst, b, h) do { _Pragma("unroll") for (int m = 0; m < 4; ++m) _Pragma("unroll") for (int k = 0; k < 2; ++k) dst[m][k] = *(const LAS bf16x8*)(lds + PG8_SA(b, h) + aoff + m * 2048 + k * 1024); } while (0)
#define PG8_LDB(dst, b, h) do { _Pragma("unroll") for (int n = 0; n < 2; ++n) _Pragma("unroll") for (int k = 0; k < 2; ++k) dst[n][k] = *(const LAS bf16x8*)(lds + PG8_SB(b, h) + boff + n * 2048 + k * 1024); } while (0)
#define PG8_MMA(ai, bj, At, Bt) do { __builtin_amdgcn_s_setprio(1); _Pragma("unroll") for (int m = 0; m < 4; ++m) _Pragma("unroll") for (int n = 0; n < 2; ++n) _Pragma("unroll") for (int k = 0; k < 2; ++k) \
        acc[ai][bj][m][n] = __builtin_amdgcn_mfma_f32_16x16x32_bf16(Bt[n][k], At[m][k], acc[ai][bj][m][n], 0, 0, 0); __builtin_amdgcn_s_setprio(0); } while (0)
#define PG8_WAIT_V(n) asm volatile("s_waitcnt vmcnt(" #n ")" ::: "memory")
#define PG8_WAIT_L(n) asm volatile("s_waitcnt lgkmcnt(" #n ")" ::: "memory")
#define PG8_BAR __builtin_amdgcn_s_barrier()
#define PG8_SCHED __builtin_amdgcn_sched_barrier(0)
    Unit cur, nxt; int ui = 0;
    if (!S.next(0, cur)) return;
    f32x4 acc[2][2][4][2];
#pragma unroll
    for (int a = 0; a < 2; ++a)
#pragma unroll
        for (int b = 0; b < 2; ++b)
#pragma unroll
            for (int m = 0; m < 4; ++m)
#pragma unroll
                for (int n = 0; n < 2; ++n) acc[a][b][m][n] = (f32x4){0.f, 0.f, 0.f, 0.f};
    bf16x8 At[4][2], B0[2][2], B1[2][2];
    const char* cA = (const char*)g.A + (size_t)cur.pm * tstep; const char* cB = (const char*)g.Bt + (size_t)cur.pn * tstep;
    S.a_ready(cur);
    if constexpr (SP2) {
        PG8_STAGE(PG8_SB(0, 0), cB, voffB); PG8_STAGE(PG8_SB(0, 1), cB + hstep, voffB); PG8_STAGE(PG8_SA(0, 0), cA, voffA); PG8_STAGE(PG8_SA(0, 1), cA + hstep, voffA);
        if (wr == 1) PG8_BAR;
        PG8_WAIT_V(2); PG8_BAR;
        PG8_STAGE(PG8_SB(1, 0), cB + kstep, voffB); PG8_STAGE(PG8_SA(1, 0), cA + kstep, voffA); PG8_STAGE(PG8_SB(1, 1), cB + hstep + kstep, voffB);
        PG8_WAIT_V(6); PG8_BAR;
    } else {
        PG8_STAGE(PG8_SB(0, 0), cB, voffB); PG8_STAGE(PG8_SA(0, 0), cA, voffA); PG8_STAGE(PG8_SB(0, 1), cB + hstep, voffB); PG8_STAGE(PG8_SA(0, 1), cA + hstep, voffA);
        if (wr == 1) PG8_BAR;
        PG8_WAIT_V(4); PG8_BAR;
        PG8_STAGE(PG8_SB(1, 0), cB + kstep, voffB); PG8_STAGE(PG8_SA(1, 0), cA + kstep, voffA); PG8_STAGE(PG8_SB(1, 1), cB + hstep + kstep, voffB);
        PG8_WAIT_V(6); PG8_BAR;
    }
    for (;;) {
        const bool has_next = S.next(ui + 1, nxt);
        const char* nA = has_next ? (const char*)g.A + (size_t)nxt.pm * tstep : cA; const char* nB = has_next ? (const char*)g.Bt + (size_t)nxt.pn * tstep : cB;
        for (int t = 0; t < nt; t += 2) {
            const bool last = (t == nt - 2);
            const char* a1 = cA + (size_t)(t + 1) * kstep;
            const char* a2 = last ? nA : cA + (size_t)(t + 2) * kstep; const char* b2 = last ? nB : cB + (size_t)(t + 2) * kstep;
            const char* a3 = a2 + kstep; const char* b3 = b2 + kstep;
            if (last && has_next) S.a_ready(nxt);
            if constexpr (SP2) {
            PG8_LDB(B0, 0, 0); PG8_LDB(B1, 0, 1); PG8_SCHED; PG8_LDA(At, 0, 0); PG8_STAGE(PG8_SA(1, 1), a1 + hstep, voffA);
            PG8_WAIT_V(8); PG8_WAIT_L(0); PG8_BAR; PG8_MMA(0, 0, At, B0); PG8_MMA(0, 1, At, B1); PG8_BAR; PG8_SCHED;
            PG8_LDA(At, 0, 1); PG8_STAGE(PG8_SB(0, 0), b2, voffB); PG8_STAGE(PG8_SB(0, 1), b2 + hstep, voffB); PG8_STAGE(PG8_SA(0, 0), a2, voffA);
            PG8_WAIT_V(8); PG8_WAIT_L(0); PG8_BAR; PG8_MMA(1, 0, At, B0); PG8_MMA(1, 1, At, B1); PG8_BAR; PG8_SCHED;
            PG8_LDB(B0, 1, 0); PG8_LDB(B1, 1, 1); PG8_SCHED; PG8_LDA(At, 1, 0); PG8_STAGE(PG8_SA(0, 1), a2 + hstep, voffA);
            PG8_WAIT_V(8); PG8_WAIT_L(0); PG8_BAR; PG8_MMA(0, 0, At, B0); PG8_MMA(0, 1, At, B1); PG8_BAR; PG8_SCHED;
            PG8_LDA(At, 1, 1); PG8_STAGE(PG8_SB(1, 0), b3, voffB); PG8_STAGE(PG8_SB(1, 1), b3 + hstep, voffB); PG8_STAGE(PG8_SA(1, 0), a3, voffA);
            PG8_WAIT_V(8); PG8_WAIT_L(0); PG8_BAR; PG8_MMA(1, 0, At, B0); PG8_MMA(1, 1, At, B1); PG8_BAR; PG8_SCHED;
            } else {
            PG8_LDB(B0, 0, 0); PG8_SCHED; PG8_LDA(At, 0, 0); PG8_STAGE(PG8_SA(1, 1), a1 + hstep, voffA);
            PG8_WAIT_L(8); PG8_BAR; PG8_WAIT_L(0); PG8_MMA(0, 0, At, B0); PG8_BAR; PG8_SCHED;
            PG8_LDB(B1, 0, 1); PG8_STAGE(PG8_SB(0, 0), b2, voffB);
            PG8_BAR; PG8_WAIT_L(0); PG8_MMA(0, 1, At, B1); PG8_BAR;
            PG8_LDA(At, 0, 1); PG8_STAGE(PG8_SA(0, 0), a2, voffA);
            PG8_BAR; PG8_WAIT_L(0); PG8_MMA(1, 0, At, B0); PG8_BAR; PG8_SCHED;
            PG8_STAGE(PG8_SB(0, 1), b2 + hstep, voffB);
            PG8_WAIT_V(6); PG8_BAR; PG8_MMA(1, 1, At, B1); PG8_BAR;
            PG8_LDB(B0, 1, 0); PG8_SCHED; PG8_LDA(At, 1, 0); PG8_STAGE(PG8_SA(0, 1), a2 + hstep, voffA);
            PG8_WAIT_L(8); PG8_BAR; PG8_WAIT_L(0); PG8_MMA(0, 0, At, B0); PG8_BAR; PG8_SCHED;
            PG8_LDB(B1, 1, 1); PG8_STAGE(PG8_SB(1, 0), b3, voffB);
            PG8_BAR; PG8_WAIT_L(0); PG8_MMA(0, 1, At, B1); PG8_BAR;
            PG8_LDA(At, 1, 1); PG8_STAGE(PG8_SA(1, 0), a3, voffA);
            PG8_BAR; PG8_WAIT_L(0); PG8_MMA(1, 0, At, B0); PG8_BAR; PG8_SCHED;
            PG8_STAGE(PG8_SB(1, 1), b3 + hstep, voffB);
            PG8_WAIT_V(6); PG8_BAR; PG8_MMA(1, 1, At, B1); PG8_BAR;
            }
        }
        if constexpr (ALIGN_EPI) { if (wr == 0) PG8_BAR; }
        if constexpr (!Epi::AFTER_DRAIN) { E(acc, cur, wr, wc, fr, fq); S.done(cur); }
        if (!has_next) break;
#pragma unroll
        for (int a = 0; a < 2; ++a)
#pragma unroll
            for (int b = 0; b < 2; ++b)
#pragma unroll
                for (int m = 0; m < 4; ++m)
#pragma unroll
                    for (int n = 0; n < 2; ++n) acc[a][b][m][n] = (f32x4){0.f, 0.f, 0.f, 0.f};
        cur = nxt; cA = nA; cB = nB; ++ui;
        if constexpr (ALIGN_EPI) { if (wr == 1) PG8_BAR; }
    }
    PG8_WAIT_V(0);
    if constexpr (!ALIGN_EPI) { if (wr == 0) PG8_BAR; }
    PG8_BAR;
#undef PG8_SA
#undef PG8_SB
#undef PG8_STAGE
#undef PG8_LDA
#undef PG8_LDB
#undef PG8_MMA
#undef PG8_WAIT_V
#undef PG8_WAIT_L
#undef PG8_BAR
#undef PG8_SCHED
}
}

constexpr size_t MiB = 1u << 20;
constexpr size_t WS_CTL = 0, CTL_ZERO_BYTES = 1 * MiB;
constexpr size_t WINT_BYTES = (size_t)NPAD * DM * 2;
constexpr size_t WS_WINT = 1 * MiB;
constexpr size_t WS_WINUA = WS_WINT + 2 * WINT_BYTES;
constexpr size_t WS_WPOOLT = WS_WINUA + 8 * MiB;
constexpr size_t WS_WBRA = WS_WPOOLT + 1 * MiB;
constexpr size_t WS_WBRB = WS_WBRA + 8 * MiB;
constexpr size_t WS_WOUT = WS_WBRB + 8 * MiB;
constexpr size_t WS_WDEC = WS_WOUT + 16 * MiB;
constexpr size_t WS_WAAA = WS_WDEC + 256 * 1024;
constexpr size_t WS_WMV = WS_WAAA + 256 * 1024;
constexpr size_t WS_RK = WS_WMV + 512 * 1024;
constexpr size_t WS_HM = WS_RK + 1 * MiB;
constexpr size_t WS_PROJ = WS_HM + 32 * MiB;
constexpr size_t WS_CW1 = WS_PROJ + (size_t)M * NPAD * 2;
constexpr size_t WS_CR2 = WS_CW1 + 16 * MiB;
constexpr size_t WS_CBK = WS_CR2 + 16 * MiB;
constexpr size_t WS_CPC = WS_CBK + 32 * MiB;
constexpr size_t WS_CU0 = WS_CPC + 2 * MiB;
constexpr size_t WS_CY0 = WS_CU0 + 32 * MiB;
constexpr size_t WS_CVO = WS_CY0 + 32 * MiB;
constexpr size_t WS_CFR = WS_CVO + 32 * MiB;
constexpr size_t WS_V0 = WS_CFR + 64 * MiB;
constexpr size_t WS_V1 = WS_V0 + 32 * MiB;
constexpr size_t WS_YA = WS_V1 + 32 * MiB;
constexpr size_t WS_YB = WS_YA + 16 * MiB;
constexpr size_t WS_END = WS_YB + 16 * MiB;
constexpr size_t WS_OUTF = WS_CW1;

constexpr int LDS_BYTES = 163840, NWAVES = 8, NTHREADS = 512;
constexpr int PSCR = 20224;
constexpr int PT_ROW = 136, PT_ARR = 17 * PT_ROW;
constexpr int NPHASES = 16;

struct Args { const float* in[26]; float* out; unsigned char* ws; int ph_lo, ph_hi; };

struct Ctx {
    LAS unsigned char* lds; int tid, lane, wave, G, bid;
    __device__ __forceinline__ void refresh() { int t = threadIdx.x; asm volatile("" : "+v"(t)); tid = t; lane = t & 63; wave = __builtin_amdgcn_readfirstlane(t >> 6); }
    float* out; unsigned char* ws;
};

__device__ __forceinline__ float wave_sum(float v) {
#pragma unroll
    for (int o = 1; o < 64; o <<= 1) v += __shfl_xor(v, o);
    return v;
}

__device__ __forceinline__ void transpose_item(const float* W, int K, int N, int nstart, int nblk, bf16_t* WT, int row_off, LAS float* scr, int item, int lane) {
    const int kb = item / nblk, nb = item % nblk, k0 = 64 * kb, n0 = nstart + 64 * nb;
    const int lr = lane >> 4, lc = (lane & 15) * 4;
#pragma unroll 8
    for (int i = 0; i < 16; ++i) { const int kk = 4 * i + lr; *(LAS f32x4*)(scr + kk * 68 + lc) = __builtin_nontemporal_load((const f32x4*)(W + (size_t)(k0 + kk) * N + n0 + lc)); }
    LDS_WAIT();
    const int c = lane & 7;
#pragma unroll
    for (int j = 0; j < 8; ++j) { const int n = (lane >> 3) + 8 * j; const LAS float* s = scr + (8 * c) * 68 + n;
        u32x4 o; o.x = cvtpk(s[0 * 68], s[1 * 68]); o.y = cvtpk(s[2 * 68], s[3 * 68]); o.z = cvtpk(s[4 * 68], s[5 * 68]); o.w = cvtpk(s[6 * 68], s[7 * 68]);
        *(u32x4*)(WT + (size_t)(row_off + n0 + n) * K + k0 + 8 * c) = o; }
    LDS_WAIT();
}
__device__ __forceinline__ void transpose_item32(const float* W, int K, int N, bf16_t* WT, int row_off, LAS float* scr, int item, int lane) {
    const int k0 = 64 * item;
#pragma unroll 8
    for (int i = 0; i < 32; ++i) { const int kk = 2 * i + (lane >> 5); scr[kk * 33 + (lane & 31)] = W[(size_t)(k0 + kk) * N + (lane & 31)]; }
    LDS_WAIT();
    const int c = lane & 7;
#pragma unroll
    for (int j = 0; j < 4; ++j) { const int n = (lane >> 3) + 8 * j; const LAS float* s = scr + (8 * c) * 33 + n;
        u32x4 o; o.x = cvtpk(s[0 * 33], s[1 * 33]); o.y = cvtpk(s[2 * 33], s[3 * 33]); o.z = cvtpk(s[4 * 33], s[5 * 33]); o.w = cvtpk(s[6 * 33], s[7 * 33]);
        *(u32x4*)(WT + (size_t)(row_off + n) * K + k0 + 8 * c) = o; }
    LDS_WAIT();
}

__device__ __forceinline__ void phase_convert(const Args& A, Ctx& F) {
    F.refresh();
    LAS float* scr = (LAS float*)(F.lds + F.wave * 17408);
    const int gw = F.bid * NWAVES + F.wave, NGW = F.G * NWAVES;
    bf16_t* WinT = (bf16_t*)(F.ws + WS_WINT); bf16_t* WpoolT = (bf16_t*)(F.ws + WS_WPOOLT);
    bf16_t* Wbra = (bf16_t*)(F.ws + WS_WBRA); bf16_t* Wbrb = (bf16_t*)(F.ws + WS_WBRB); bf16_t* Wout = (bf16_t*)(F.ws + WS_WOUT);
    bf16_t* Wdec = (bf16_t*)(F.ws + WS_WDEC); bf16_t* Waaa = (bf16_t*)(F.ws + WS_WAAA); bf16_t* Wmv = (bf16_t*)(F.ws + WS_WMV);
    constexpr int I_IN = 32 * 146, I_BR = 16 * 32, I_OUT = 32 * 32, I_POOL = 4 * 4, I_LORA = 16, I_MVD = 32;
    constexpr int PER_L = I_IN + 2 * I_BR + I_OUT + 4 * I_POOL + 2 * I_LORA;
    constexpr int NITEMS = 2 * PER_L + I_MVD;
    for (int it = gw; it < NITEMS; it += NGW) {
        int r = it;
        if (r >= 2 * PER_L) { r -= 2 * PER_L; transpose_item32(A.in[13], DM, 32, WinT + (size_t)NPAD * DM, C_MV, scr, r, F.lane); continue; }
        const int l = r / PER_L; r -= l * PER_L;
        if (r < I_IN) { transpose_item(A.in[5] + (size_t)l * DM * NIN, DM, NIN, 1024, 146, WinT + (size_t)l * NPAD * DM, 0, scr, r, F.lane); continue; } r -= I_IN;
        if (r < I_BR) { transpose_item(A.in[22] + (size_t)l * PW * DM, PW, DM, 0, 32, Wbra + (size_t)l * DM * PW, 0, scr, r, F.lane); continue; } r -= I_BR;
        if (r < I_BR) { transpose_item(A.in[23] + (size_t)l * RW * DM, RW, DM, 0, 32, Wbrb + (size_t)l * DM * RW, 0, scr, r, F.lane); continue; } r -= I_BR;
        if (r < I_OUT) { transpose_item(A.in[24] + (size_t)l * DM * DM, DM, DM, 0, 32, Wout + (size_t)l * DM * DM, 0, scr, r, F.lane); continue; } r -= I_OUT;
        if (r < 4 * I_POOL) { const int g = r / I_POOL; r -= g * I_POOL;
            transpose_item(A.in[6] + (size_t)(l * 4 + g) * 65536, 256, 256, 0, 4, WpoolT + (size_t)(l * 4 + g) * 65536, 0, scr, r, F.lane); continue; } r -= 4 * I_POOL;
        if (r < I_LORA) { transpose_item(A.in[9] + (size_t)l * 64 * RW, 64, RW, 0, 16, Wdec + (size_t)l * RW * 64, 0, scr, r, F.lane); continue; } r -= I_LORA;
        transpose_item(A.in[11] + (size_t)l * 64 * RW, 64, RW, 0, 16, Waaa + (size_t)l * RW * 64, 0, scr, r, F.lane);
    }
    const int gt = F.bid * NTHREADS + F.tid, NGT = F.G * NTHREADS;
    { bf16_t* WinUa = (bf16_t*)(F.ws + WS_WINUA);
      for (int e0 = gt; e0 < 2 * DM * 256; e0 += 8 * NGT) {
          f32x4 v[8];
#pragma unroll
          for (int k8 = 0; k8 < 8; ++k8) { const int e = e0 + k8 * NGT; const int c4 = e & 255, k = (e >> 8) & 2047, l = e >> 19; const int g = c4 >> 6, c = (c4 & 63) * 4;
              if (e < 2 * DM * 256) v[k8] = __builtin_nontemporal_load((const f32x4*)(A.in[5] + ((size_t)l * DM + k) * NIN + g * 256 + c)); }
#pragma unroll
          for (int k8 = 0; k8 < 8; ++k8) { const int e = e0 + k8 * NGT; const int c4 = e & 255, k = (e >> 8) & 2047, l = e >> 19; const int g = c4 >> 6, c = (c4 & 63) * 4;
              if (e < 2 * DM * 256) { u32x2 o; o.x = cvtpk(v[k8][0], v[k8][1]); o.y = cvtpk(v[k8][2], v[k8][3]);
                  *(u32x2*)(WinUa + ((size_t)(l * 4 + g) * DM + k) * 256 + c) = o; } } } }
    { u32x4 z = {0u, 0u, 0u, 0u};
      for (int e = gt; e < 128 * DM / 8; e += NGT) *(u32x4*)(WinT + (size_t)C_MV * DM + (size_t)e * 8) = z;
      for (int e = gt; e < 96 * DM / 8; e += NGT) *(u32x4*)(WinT + (size_t)NPAD * DM + (size_t)(C_MV + 32) * DM + (size_t)e * 8) = z; }
    for (int e = gt; e < 32 * RW; e += NGT) { const int k = e & 31, n = e >> 5; Wmv[n * 32 + k] = (bf16_t)f2bf(A.in[15][(size_t)k * RW + n]); }
    __syncthreads();
    if (F.bid < 192) {
        float* mod = (float*)(F.ws + WS_CTL);
        LAS f32x4* cond = (LAS f32x4*)(F.lds);
        LAS float* red = (LAS float*)(F.lds + 32768);
        const int l = F.bid / 96, j0 = (F.bid % 96) * 64;
        for (int i = F.tid; i < DM; i += NTHREADS) { f32x4 cv; cv[0] = silu(A.in[1][i]); cv[1] = silu(A.in[1][DM + i]); cv[2] = silu(A.in[1][2 * DM + i]); cv[3] = silu(A.in[1][3 * DM + i]); cond[i] = cv; }
        __syncthreads();
        const int sub = F.lane >> 4, cl = (F.lane & 15) * 4;
        const float* w = A.in[2] + ((size_t)l * DM + F.wave * 256 + sub) * 6144 + j0 + cl;
        f32x4 a0 = {0, 0, 0, 0}, a1 = a0, a2 = a0, a3 = a0;
#pragma unroll 8
        for (int i = 0; i < 64; ++i) { const f32x4 wv = __builtin_nontemporal_load((const f32x4*)(w + (size_t)(4 * i) * 6144)); const f32x4 cv = cond[F.wave * 256 + 4 * i + sub];
            a0 += wv * cv[0]; a1 += wv * cv[1]; a2 += wv * cv[2]; a3 += wv * cv[3]; }
#pragma unroll
        for (int i = 0; i < 4; ++i) {
            a0[i] += __shfl_xor(a0[i], 16); a0[i] += __shfl_xor(a0[i], 32); a1[i] += __shfl_xor(a1[i], 16); a1[i] += __shfl_xor(a1[i], 32);
            a2[i] += __shfl_xor(a2[i], 16); a2[i] += __shfl_xor(a2[i], 32); a3[i] += __shfl_xor(a3[i], 16); a3[i] += __shfl_xor(a3[i], 32); }
        if (sub == 0) { *(LAS f32x4*)(red + (F.wave * 4 + 0) * 64 + cl) = a0; *(LAS f32x4*)(red + (F.wave * 4 + 1) * 64 + cl) = a1;
                        *(LAS f32x4*)(red + (F.wave * 4 + 2) * 64 + cl) = a2; *(LAS f32x4*)(red + (F.wave * 4 + 3) * 64 + cl) = a3; }
        __syncthreads();
        if (F.tid < 256) { const int b = F.tid >> 6, jj = F.tid & 63; float sacc = 0.f;
#pragma unroll
            for (int wv = 0; wv < 8; ++wv) sacc += red[(wv * 4 + b) * 64 + jj];
            mod[(size_t)(l * 4 + b) * 6144 + j0 + jj] = sacc + A.in[3][(size_t)l * 6144 + j0 + jj]; }
        __syncthreads();
    }
}

__device__ __forceinline__ void phase_rows(const Args& A, Ctx& F, int mode, int first = -1, int stride = 0, int count = 0) {
    F.refresh();
    { const int gw_ = F.bid * NWAVES + F.wave, NGW_ = F.G * NWAVES; if (first < 0) { first = gw_; stride = NGW_; count = (M - 1 - gw_) / NGW_ + 1; } }
    const int mend = first + count * stride;
    const float* mod = (const float*)(F.ws + WS_CTL);
    const bf16_t* outb = (const bf16_t*)(F.ws + WS_OUTF);
    bf16_t* hbuf = (bf16_t*)(F.ws + WS_HM);
    const int lprev = (mode == 2) ? 1 : 0;
    const int lnext = (mode == 0) ? 0 : 1;
    const float* xsrc = (mode == 2) ? F.out : A.in[0];
    f32x4 xn[8]; u32x2 on[8];
#define ROWS_LOAD(mm) do { _Pragma("unroll") for (int j = 0; j < 8; ++j) { xn[j] = *(const f32x4*)(xsrc + (size_t)(mm) * DM + j * 256 + F.lane * 4); \
        if (mode != 0) on[j] = __builtin_nontemporal_load((const u32x2*)(outb + (size_t)(mm) * DM + j * 256 + F.lane * 4)); } } while (0)
    if (count > 0) ROWS_LOAD(first);
    for (int m = first; m < mend; m += stride) {
        const int b = m >> 11;
        f32x4 xv[8]; u32x2 ob[8];
#pragma unroll
        for (int j = 0; j < 8; ++j) { xv[j] = xn[j]; ob[j] = on[j]; }
        if (m + stride < mend) ROWS_LOAD(m + stride);
        if (mode != 0) {
            f32x4 ov[8]; float ss = 0.f;
#pragma unroll
            for (int j = 0; j < 8; ++j) { ov[j] = (f32x4){bflo(ob[j].x), bfhi(ob[j].x), bflo(ob[j].y), bfhi(ob[j].y)};
                ss += ov[j][0] * ov[j][0] + ov[j][1] * ov[j][1] + ov[j][2] * ov[j][2] + ov[j][3] * ov[j][3]; }
            const float rs = rsqrtf(wave_sum(ss) * (1.f / DM) + RMS_EPS);
            const float* gm = mod + (size_t)(lprev * 4 + b) * 6144 + 4096; const float* gp = A.in[25] + (size_t)lprev * DM;
#pragma unroll
            for (int j = 0; j < 8; ++j) { const int c = j * 256 + F.lane * 4;
                const f32x4 gt = *(const f32x4*)(gm + c); const f32x4 gpo = *(const f32x4*)(gp + c);
                xv[j] += gt * (ov[j] * rs * gpo);
                *(f32x4*)(F.out + (size_t)m * DM + c) = xv[j]; }
        }
        if (mode != 2) {
            float ss = 0.f;
#pragma unroll
            for (int j = 0; j < 8; ++j) ss += xv[j][0] * xv[j][0] + xv[j][1] * xv[j][1] + xv[j][2] * xv[j][2] + xv[j][3] * xv[j][3];
            const float rs = rsqrtf(wave_sum(ss) * (1.f / DM) + RMS_EPS);
            const float* mm = mod + (size_t)(lnext * 4 + b) * 6144; const float* gpre = A.in[4] + (size_t)lnext * DM;
#pragma unroll
            for (int j = 0; j < 8; ++j) { const int c = j * 256 + F.lane * 4;
                const f32x4 sh = *(const f32x4*)(mm + c); const f32x4 sc = *(const f32x4*)(mm + 2048 + c); const f32x4 g = *(const f32x4*)(gpre + c);
                const f32x4 hv = (xv[j] * rs * g) * (sc + 1.f) + sh;
                u32x2 o; o.x = cvtpk(hv[0], hv[1]); o.y = cvtpk(hv[2], hv[3]);
                *(u32x2*)(hbuf + (size_t)m * DM + c) = o; }
        }
    }
#undef ROWS_LOAD
}

template <int W> __device__ __forceinline__ void ya_item(const bf16_t* proj, bf16_t* ya, const float* pscale, int m0, int tid) {
    const int c = 2 * tid; const int p0 = m0 & (SEQ - 1);
    const bf16_t* base = proj + (size_t)m0 * NPAD + c;
    float r0[W - 1 + 16], r1[W - 1 + 16];
#pragma unroll
    for (int i = 0; i < W - 1; ++i) { unsigned u = 0u; if (p0 > 0) u = *(const unsigned*)(base - (ptrdiff_t)(W - 1 - i) * NPAD); r0[i] = bflo(u); r1[i] = bfhi(u); }
#pragma unroll
    for (int i = 0; i < 16; ++i) { const unsigned u = *(const unsigned*)(base + (size_t)i * NPAD); r0[W - 1 + i] = bflo(u); r1[W - 1 + i] = bfhi(u); }
    const float ps0 = pscale[c], ps1 = pscale[c + 1];
    float s0 = 0.f, s1 = 0.f;
#pragma unroll
    for (int d = 0; d < W - 1; ++d) { s0 += r0[d]; s1 += r1[d]; }
#pragma unroll
    for (int i = 0; i < 16; ++i) {
        s0 += r0[W - 1 + i]; s1 += r1[W - 1 + i];
        if (i > 0) { s0 -= r0[i - 1]; s1 -= r1[i - 1]; }
        const int p = p0 + i; const float inv = __builtin_amdgcn_rcpf((float)((p + 1 < W) ? (p + 1) : W));
        const unsigned z = *(const unsigned*)(base + (size_t)i * NPAD + C_ZA);
        const float y0 = (s0 * inv - r0[W - 1 + i]) * ps0 * silu(bflo(z)), y1 = (s1 * inv - r1[W - 1 + i]) * ps1 * silu(bfhi(z));
        *(unsigned*)(ya + (size_t)(m0 + i) * PW + c) = cvtpk(y0, y1);
    }
}

__device__ __forceinline__ void shift8(const u32x4 cu, const u32x4 pv, const float* mu, float* o) {
    const f32x4 m0 = *(const f32x4*)mu, m1 = *(const f32x4*)(mu + 4);
    float z, p;
    z = bflo(cu.x); p = bflo(pv.x); o[0] = z + (p - z) * m0[0];  z = bfhi(cu.x); p = bfhi(pv.x); o[1] = z + (p - z) * m0[1];
    z = bflo(cu.y); p = bflo(pv.y); o[2] = z + (p - z) * m0[2];  z = bfhi(cu.y); p = bfhi(pv.y); o[3] = z + (p - z) * m0[3];
    z = bflo(cu.z); p = bflo(pv.z); o[4] = z + (p - z) * m1[0];  z = bfhi(cu.z); p = bfhi(pv.z); o[5] = z + (p - z) * m1[1];
    z = bflo(cu.w); p = bflo(pv.w); o[6] = z + (p - z) * m1[2];  z = bfhi(cu.w); p = bfhi(pv.w); o[7] = z + (p - z) * m1[3];
}
__device__ __forceinline__ bf16x8 pack8(const float* o) {
    u32x4 w; w.x = cvtpk(o[0], o[1]); w.y = cvtpk(o[2], o[3]); w.z = cvtpk(o[4], o[5]); w.w = cvtpk(o[6], o[7]);
    return __builtin_bit_cast(bf16x8, w);
}
__device__ __forceinline__ void shift4(const u32x2 cu, const u32x2 pv, const f32x4 mu, float* o) {
    float z, p;
    z = bflo(cu.x); p = bflo(pv.x); o[0] = z + (p - z) * mu[0];  z = bfhi(cu.x); p = bfhi(pv.x); o[1] = z + (p - z) * mu[1];
    z = bflo(cu.y); p = bflo(pv.y); o[2] = z + (p - z) * mu[2];  z = bfhi(cu.y); p = bfhi(pv.y); o[3] = z + (p - z) * mu[3];
}


#define DPPF(x, ctrl) __builtin_bit_cast(float, __builtin_amdgcn_update_dpp(0, __builtin_bit_cast(int, (x)), (ctrl), 0xF, 0xF, true))
__device__ __forceinline__ float scan16(float x) { x += DPPF(x, 0x111); x += DPPF(x, 0x112); x += DPPF(x, 0x114); x += DPPF(x, 0x118); return x; }
__device__ __forceinline__ float sum16(float x) { x += DPPF(x, 0xB1); x += DPPF(x, 0x4E); x += DPPF(x, 0x124); x += DPPF(x, 0x128); return x; }
__device__ __forceinline__ bf16x8 pack44(const float* lo, const float* hi) {
    u32x4 w; w.x = cvtpk(lo[0], lo[1]); w.y = cvtpk(lo[2], lo[3]); w.z = cvtpk(hi[0], hi[1]); w.w = cvtpk(hi[2], hi[3]); return __builtin_bit_cast(bf16x8, w);
}
__device__ __forceinline__ void chunk_tail(LAS unsigned char* scr, int lane, unsigned char* ws, size_t pi, const float* vbase) {
    const int i = lane & 15, q = lane >> 4;
    LAS float* Mab = (LAS float*)scr; LAS float* Mak = Mab + 256; LAS float* Mrb = Mab + 512; LAS float* Mrk = Mab + 768;
    LAS float* AtL = (LAS float*)(scr + 4096); LAS float* RtL = (LAS float*)(scr + 8192); LAS float* VL = (LAS float*)(scr + 12288);
    bf16x8 fa[2], fr[2], fb[2], fk[2];
    {   const unsigned char* fg = ws + WS_CFR + pi * 8192 + (size_t)lane * 16;
        u32x4 ua[2], ur[2];
        ua[0] = *(const u32x4*)(fg); ua[1] = *(const u32x4*)(fg + 1024); ur[0] = *(const u32x4*)(fg + 2048); ur[1] = *(const u32x4*)(fg + 3072);
        fb[0] = *(const bf16x8*)(fg + 4096); fb[1] = *(const bf16x8*)(fg + 5120); fk[0] = *(const bf16x8*)(fg + 6144); fk[1] = *(const bf16x8*)(fg + 7168);
        fa[0] = __builtin_bit_cast(bf16x8, ua[0]); fa[1] = __builtin_bit_cast(bf16x8, ua[1]); fr[0] = __builtin_bit_cast(bf16x8, ur[0]); fr[1] = __builtin_bit_cast(bf16x8, ur[1]);
#pragma unroll
        for (int ks = 0; ks < 2; ++ks) {
            *(LAS f32x4*)(AtL + i * 64 + 16 * (2 * ks) + 4 * q) = (f32x4){bflo(ua[ks].x), bfhi(ua[ks].x), bflo(ua[ks].y), bfhi(ua[ks].y)};
            *(LAS f32x4*)(AtL + i * 64 + 16 * (2 * ks + 1) + 4 * q) = (f32x4){bflo(ua[ks].z), bfhi(ua[ks].z), bflo(ua[ks].w), bfhi(ua[ks].w)};
            *(LAS f32x4*)(RtL + i * 64 + 16 * (2 * ks) + 4 * q) = (f32x4){bflo(ur[ks].x), bfhi(ur[ks].x), bflo(ur[ks].y), bfhi(ur[ks].y)};
            *(LAS f32x4*)(RtL + i * 64 + 16 * (2 * ks + 1) + 4 * q) = (f32x4){bflo(ur[ks].z), bfhi(ur[ks].z), bflo(ur[ks].w), bfhi(ur[ks].w)};
        }
#pragma unroll
        for (int ct = 0; ct < 4; ++ct) *(LAS f32x4*)(VL + i * 64 + 16 * ct + 4 * q) = *(const f32x4*)(vbase + (size_t)i * RW + 16 * ct + 4 * q);
    }
    {   f32x4 gab = {0, 0, 0, 0}, gak = gab, grb = gab, grk = gab;
#pragma unroll
        for (int ks = 0; ks < 2; ++ks) {
            gab = __builtin_amdgcn_mfma_f32_16x16x32_bf16(fa[ks], fb[ks], gab, 0, 0, 0); gak = __builtin_amdgcn_mfma_f32_16x16x32_bf16(fa[ks], fk[ks], gak, 0, 0, 0);
            grb = __builtin_amdgcn_mfma_f32_16x16x32_bf16(fr[ks], fb[ks], grb, 0, 0, 0); grk = __builtin_amdgcn_mfma_f32_16x16x32_bf16(fr[ks], fk[ks], grk, 0, 0, 0);
        }
        f32x4 mab, mak, mrb, mrk;
#pragma unroll
        for (int jj = 0; jj < 4; ++jj) { const int row = 4 * q + jj;
            mab[jj] = (i < row) ? gab[jj] : 0.f; mak[jj] = (i < row) ? gak[jj] : 0.f; mrb[jj] = (i <= row) ? grb[jj] : 0.f; mrk[jj] = (i <= row) ? grk[jj] : 0.f; }
        *(LAS f32x4*)(Mab + i * 16 + 4 * q) = mab; *(LAS f32x4*)(Mak + i * 16 + 4 * q) = mak; *(LAS f32x4*)(Mrb + i * 16 + 4 * q) = mrb; *(LAS f32x4*)(Mrk + i * 16 + 4 * q) = mrk;
    }
    LDS_WAIT();
    {   const int c = lane; f32x4 xv[4], rv[4]; LAS float* Mp = Mab; LAS float* Mq = Mrb;
#pragma unroll
        for (int g = 0; g < 4; ++g) { xv[g] = (f32x4){AtL[(4 * g) * 64 + c], AtL[(4 * g + 1) * 64 + c], AtL[(4 * g + 2) * 64 + c], AtL[(4 * g + 3) * 64 + c]};
                                      rv[g] = (f32x4){RtL[(4 * g) * 64 + c], RtL[(4 * g + 1) * 64 + c], RtL[(4 * g + 2) * 64 + c], RtL[(4 * g + 3) * 64 + c]}; }
#pragma unroll
        for (int j = 0; j < 15; ++j) { const float xj = xv[j >> 2][j & 3];
#pragma unroll
            for (int g = (j + 1) >> 2; g < 4; ++g) xv[g] += *(const LAS f32x4*)(Mp + j * 16 + 4 * g) * xj;
            asm volatile("" : "+v"(Mp), "+v"(xv[3][3])); }
#pragma unroll
        for (int j = 0; j < 16; ++j) { const float xj = xv[j >> 2][j & 3];
#pragma unroll
            for (int g = j >> 2; g < 4; ++g) rv[g] += *(const LAS f32x4*)(Mq + j * 16 + 4 * g) * xj;
            asm volatile("" : "+v"(Mq), "+v"(rv[3][3])); }
        LDS_WAIT();
        LAS bf16_t* w1s = (LAS bf16_t*)(scr + 4096); LAS bf16_t* r2s = (LAS bf16_t*)(scr + 4096 + 2048);
        const int ks = c >> 5, jj = ((c >> 4) & 1) * 4 + (c & 3), qt = (c >> 2) & 3;
#pragma unroll
        for (int ii = 0; ii < 16; ++ii) { const int idx = (ks * 64 + qt * 16 + ii) * 8 + jj; w1s[idx] = (bf16_t)cvtpk(xv[ii >> 2][ii & 3], 0.f); r2s[idx] = (bf16_t)cvtpk(rv[ii >> 2][ii & 3], 0.f); }
        LDS_WAIT();
#pragma unroll
        for (int k2 = 0; k2 < 2; ++k2) {
            const u32x4 w1 = *(const LAS u32x4*)(scr + 4096 + (k2 * 64 + lane) * 16), rr = *(const LAS u32x4*)(scr + 4096 + 2048 + (k2 * 64 + lane) * 16);
            *(u32x4*)(ws + WS_CW1 + pi * 2048 + (size_t)(k2 * 64 + lane) * 16) = w1; *(u32x4*)(ws + WS_CR2 + pi * 2048 + (size_t)(k2 * 64 + lane) * 16) = rr; }
    }
    {   const int vv = lane; f32x4 vc[4], uv[4], yv[4];
        LAS float* Mab2 = Mab; LAS float* Mak2 = Mak; LAS float* Mrb2 = Mrb; LAS float* Mrk2 = Mrk;
        asm volatile("" : "+v"(Mab2), "+v"(Mak2), "+v"(Mrb2), "+v"(Mrk2));
#pragma unroll
        for (int g = 0; g < 4; ++g) { vc[g] = (f32x4){VL[(4 * g) * 64 + vv], VL[(4 * g + 1) * 64 + vv], VL[(4 * g + 2) * 64 + vv], VL[(4 * g + 3) * 64 + vv]};
                                      uv[g] = (f32x4){0.f, 0.f, 0.f, 0.f}; yv[g] = (f32x4){0.f, 0.f, 0.f, 0.f}; }
#pragma unroll
        for (int j = 0; j < 15; ++j) { const float vj = vc[j >> 2][j & 3];
#pragma unroll
            for (int g = (j + 1) >> 2; g < 4; ++g) uv[g] += *(const LAS f32x4*)(Mak2 + j * 16 + 4 * g) * vj;
            asm volatile("" : "+v"(Mak2), "+v"(uv[3][3])); }
#pragma unroll
        for (int j = 0; j < 15; ++j) { const float uj = uv[j >> 2][j & 3];
#pragma unroll
            for (int g = (j + 1) >> 2; g < 4; ++g) uv[g] += *(const LAS f32x4*)(Mab2 + j * 16 + 4 * g) * uj;
            asm volatile("" : "+v"(Mab2), "+v"(uv[3][3])); }
#pragma unroll
        for (int j = 0; j < 16; ++j) { const float uj = uv[j >> 2][j & 3], vj = vc[j >> 2][j & 3];
#pragma unroll
            for (int g = j >> 2; g < 4; ++g) yv[g] += *(const LAS f32x4*)(Mrb2 + j * 16 + 4 * g) * uj + *(const LAS f32x4*)(Mrk2 + j * 16 + 4 * g) * vj;
            asm volatile("" : "+v"(Mrb2), "+v"(Mrk2), "+v"(yv[3][3])); }
        const int vs = vv >> 4;
#pragma unroll
        for (int qt = 0; qt < 4; ++qt) { const size_t off = pi * 4096 + (size_t)(vs * 64 + qt * 16 + (vv & 15)) * 16;
            *(f32x4*)(ws + WS_CU0 + off) = uv[qt]; *(f32x4*)(ws + WS_CY0 + off) = yv[qt]; *(f32x4*)(ws + WS_CVO + off) = vc[qt]; }
    }
    LDS_WAIT();
}

__device__ __forceinline__ void phase_prep(const Args& A, Ctx& F, int l) {
    F.refresh();
    const bf16_t* proj = (const bf16_t*)(F.ws + WS_PROJ);
    bf16_t* ya = (bf16_t*)(F.ws + WS_YA);
    float* sV = (float*)(F.ws + (l == 0 ? WS_V0 : WS_V1)); const float* vfirst = (const float*)(F.ws + WS_V0);
    float* rk = (float*)(F.ws + WS_RK);
    const bf16_t* WdecT = (const bf16_t*)(F.ws + WS_WDEC) + (size_t)l * RW * 64; const bf16_t* WaaaT = (const bf16_t*)(F.ws + WS_WAAA) + (size_t)l * RW * 64;
    const bf16_t* WmvT = (const bf16_t*)(F.ws + WS_WMV);
    const float* mu = A.in[8] + (size_t)l * 4224;
    const float* w0 = A.in[10] + l * RW; const float* a0 = A.in[12] + l * RW; const float* kk_ = A.in[17] + l * RW; const float* ka_ = A.in[18] + l * RW;
    const float* rk_ = A.in[19] + l * RW; const float* mv0 = A.in[16]; const float* mumv = A.in[14];
    const float* pscale = A.in[7] + l * PW;
    for (int rep9 = 0; rep9 < NREP(9); ++rep9)
    for (int u = F.bid; u < M / 16; u += F.G) {
        const int m0 = u * 16; const int g = F.tid >> 7;
        if (g == 0) ya_item<2>(proj, ya, pscale, m0, F.tid); else if (g == 1) ya_item<4>(proj, ya, pscale, m0, F.tid);
        else if (g == 2) ya_item<8>(proj, ya, pscale, m0, F.tid); else ya_item<16>(proj, ya, pscale, m0, F.tid);
    }
    asm volatile("" ::: "memory");
    for (int rep10 = 0; rep10 < NREP(10); ++rep10)
    for (int u = F.bid; u < M / 16; u += F.G) {
        const int m0 = u * 16;
        int lane = F.lane; asm volatile("" : "+v"(lane));
        const int tk = lane & 15, q = lane >> 4;
        const int m = m0 + tk; const bool hasprev = (m & (SEQ - 1)) != 0;
        int ozu = 0; asm volatile("" : "+v"(ozu));
        const bf16_t* prow = proj + (size_t)m * NPAD; const bf16_t* pprev = prow - NPAD;
        LAS unsigned char* scr = F.lds + F.wave * PSCR;
        LAS bf16_t* tile = (LAS bf16_t*)(scr + 4096);
        {
            const bool seq0 = (m0 & (SEQ - 1)) == 0;
            u32x4 tv[13];
#pragma unroll
            for (int i = 0; i < 13; ++i) { const int e = lane + 64 * i; const int arr = e / 272, rem = e - arr * 272, row = rem >> 4, c16 = rem & 15;
                tv[i] = (u32x4){0u, 0u, 0u, 0u};
                if (e < 816 && !(row == 0 && seq0)) tv[i] = *(const u32x4*)(proj + (size_t)(m0 - 1 + row) * NPAD + C_R + arr * 1024 + F.wave * 128 + c16 * 8); }
#pragma unroll
            for (int i = 0; i < 13; ++i) { const int e = lane + 64 * i; const int arr = e / 272, rem = e - arr * 272, row = rem >> 4, c16 = rem & 15;
                if (e < 816) *(LAS u32x4*)(tile + arr * PT_ARR + row * PT_ROW + c16 * 8) = tv[i]; }
            LDS_WAIT();
        }
        bf16x8 Bw[2], Ba[2], Bm;
        const u32x4 zero4 = {0u, 0u, 0u, 0u};
#pragma unroll
        for (int ks = 0; ks < 2; ++ks) {
            float o[8];
            { const int col = C_WLO + ks * 32 + q * 8; const u32x4 cu = *(const u32x4*)(prow + col); const u32x4 pv = hasprev ? *(const u32x4*)(pprev + col) : zero4;
              shift8(cu, pv, mu + 4096 + ks * 32 + q * 8 + ozu, o);
#pragma unroll
              for (int i = 0; i < 8; ++i) o[i] = tanh_(o[i]);
              Bw[ks] = pack8(o); }
            { const int col = C_ALO + ks * 32 + q * 8; const u32x4 cu = *(const u32x4*)(prow + col); const u32x4 pv = hasprev ? *(const u32x4*)(pprev + col) : zero4;
              shift8(cu, pv, mu + 4160 + ks * 32 + q * 8 + ozu, o); Ba[ks] = pack8(o); }
        }
        if (l == 1) { float o[8]; const int col = C_MV + q * 8; const u32x4 cu = *(const u32x4*)(prow + col); const u32x4 pv = hasprev ? *(const u32x4*)(pprev + col) : zero4;
            shift8(cu, pv, mumv + q * 8 + ozu, o); Bm = pack8(o); } else Bm = (bf16x8){0, 0, 0, 0, 0, 0, 0, 0};
#pragma unroll 1
        for (int hh2 = 0; hh2 < 2; ++hh2) {
            const int hh = F.wave * 2 + hh2;
            int oz = 0; asm volatile("" : "+v"(oz));
            float ssq = 0.f, rks = 0.f;
            LAS bf16_t* bk = (LAS bf16_t*)scr;
            const LAS bf16_t* trow = tile + (tk + 1) * PT_ROW + hh2 * 64 + 4 * q;
#pragma unroll
            for (int ct = 0; ct < 4; ++ct) { const int cl = hh * 64 + ct * 16 + 4 * q + oz; float kt[4];
                const u32x2 cu = *(const LAS u32x2*)(trow + PT_ARR + ct * 16), pv = *(const LAS u32x2*)(trow + PT_ARR - PT_ROW + ct * 16); shift4(cu, pv, *(const f32x4*)(mu + 1024 + cl), kt);
                const f32x4 kkv = *(const f32x4*)(kk_ + cl);
#pragma unroll
                for (int j = 0; j < 4; ++j) { const float kr = kt[j] * kkv[j]; ssq += kr * kr; } }
            ssq += __shfl_xor(ssq, 16); ssq += __shfl_xor(ssq, 32);
            const float inv = __builtin_amdgcn_rsqf(fmaxf(ssq, 1e-24f));
            u32x4 fa, fr, fb, fk;
            unsigned char* fg = F.ws + WS_CFR + ((size_t)u * NH + hh) * 8192 + (size_t)lane * 16;
#pragma unroll
            for (int ct = 0; ct < 4; ++ct) {
                const int c0 = hh * 64 + ct * 16, cl = c0 + 4 * q + oz, wrow = c0 + tk + oz;
                f32x4 dd = {0, 0, 0, 0}, da = {0, 0, 0, 0}, dm = {0, 0, 0, 0};
#pragma unroll
                for (int ks = 0; ks < 2; ++ks) {
                    const bf16x8 ad = *(const bf16x8*)(WdecT + (size_t)wrow * 64 + ks * 32 + q * 8), aa = *(const bf16x8*)(WaaaT + (size_t)wrow * 64 + ks * 32 + q * 8);
                    dd = __builtin_amdgcn_mfma_f32_16x16x32_bf16(ad, Bw[ks], dd, 0, 0, 0);
                    da = __builtin_amdgcn_mfma_f32_16x16x32_bf16(aa, Ba[ks], da, 0, 0, 0);
                }
                if (l == 1) { const bf16x8 am = *(const bf16x8*)(WmvT + (size_t)wrow * 32 + q * 8); dm = __builtin_amdgcn_mfma_f32_16x16x32_bf16(am, Bm, dm, 0, 0, 0); }
                float rs[4], ks_[4], vs[4];
                { const u32x2 cu = *(const LAS u32x2*)(trow + ct * 16), pv = *(const LAS u32x2*)(trow - PT_ROW + ct * 16); shift4(cu, pv, *(const f32x4*)(mu + cl), rs); }
                { const u32x2 cu = *(const LAS u32x2*)(trow + PT_ARR + ct * 16), pv = *(const LAS u32x2*)(trow + PT_ARR - PT_ROW + ct * 16); shift4(cu, pv, *(const f32x4*)(mu + 1024 + cl), ks_); }
                { const u32x2 cu = *(const LAS u32x2*)(trow + 2 * PT_ARR + ct * 16), pv = *(const LAS u32x2*)(trow + 2 * PT_ARR - PT_ROW + ct * 16); shift4(cu, pv, *(const f32x4*)(mu + 2048 + cl), vs); }
                const f32x4 w0v = *(const f32x4*)(w0 + cl), a0v = *(const f32x4*)(a0 + cl), kkv = *(const f32x4*)(kk_ + cl), kav = *(const f32x4*)(ka_ + cl), rkv = *(const f32x4*)(rk_ + cl);
                if (l == 1) { const f32x4 mv0v = *(const f32x4*)(mv0 + cl); const f32x4 vf = *(const f32x4*)(vfirst + (size_t)m * RW + cl);
#pragma unroll
                    for (int j = 0; j < 4; ++j) vs[j] = vs[j] + (vf[j] - vs[j]) * sigm(mv0v[j] + dm[j]); }
                float At[4], Rt[4], Bh[4], Kh[4], pcv4[4];
#pragma unroll
                for (int j = 0; j < 4; ++j) {
                    const float lwv = -0.6065306597f * sigm(w0v[j] + dd[j]);
                    const float as = sigm(a0v[j] + da[j]);
                    const float kn = ks_[j] * kkv[j] * inv, av = -kn, bv = kn * as;
                    const float k2 = ks_[j] * (1.f + (as - 1.f) * kav[j]);
                    rks += rs[j] * k2 * rkv[j];
                    const float L = scan16(lwv);
                    const float e2 = __expf(L), e3 = __builtin_amdgcn_rcpf(e2);
                    const float e1 = __builtin_bit_cast(float, __builtin_amdgcn_update_dpp(0x3f800000, __builtin_bit_cast(int, e2), 0x111, 0xF, 0xF, false));
                    const float pcv = __builtin_bit_cast(float, __builtin_amdgcn_update_dpp(0, __builtin_bit_cast(int, e2), 0x15F, 0xF, 0xF, true));
                    const float e4 = pcv * e3;
                    At[j] = av * e1; Rt[j] = rs[j] * e2; Bh[j] = bv * e3; Kh[j] = k2 * e3; pcv4[j] = pcv;
                    const int idx = ((ct * 64 + (tk >> 2) * 16 + 4 * q + j) * 8 + (tk & 3)); bk[idx] = (bf16_t)cvtpk(bv * e4, 0.f); bk[idx + 4] = (bf16_t)cvtpk(k2 * e4, 0.f);
                }
                const f32x4 v4 = {vs[0], vs[1], vs[2], vs[3]};
                *(f32x4*)(sV + (size_t)m * RW + cl) = v4;
                if (tk == 0) *(f32x4*)(F.ws + WS_CPC + ((size_t)u * NH + hh) * 256 + (size_t)(16 * ct + 4 * q) * 4) = (f32x4){pcv4[0], pcv4[1], pcv4[2], pcv4[3]};
                if ((ct & 1) == 0) { fa.x = cvtpk(At[0], At[1]); fa.y = cvtpk(At[2], At[3]); fr.x = cvtpk(Rt[0], Rt[1]); fr.y = cvtpk(Rt[2], Rt[3]);
                                     fb.x = cvtpk(Bh[0], Bh[1]); fb.y = cvtpk(Bh[2], Bh[3]); fk.x = cvtpk(Kh[0], Kh[1]); fk.y = cvtpk(Kh[2], Kh[3]); }
                else               { fa.z = cvtpk(At[0], At[1]); fa.w = cvtpk(At[2], At[3]); fr.z = cvtpk(Rt[0], Rt[1]); fr.w = cvtpk(Rt[2], Rt[3]);
                                     fb.z = cvtpk(Bh[0], Bh[1]); fb.w = cvtpk(Bh[2], Bh[3]); fk.z = cvtpk(Kh[0], Kh[1]); fk.w = cvtpk(Kh[2], Kh[3]);
                                     const int ks2 = ct >> 1;
                                     *(u32x4*)(fg + ks2 * 1024) = fa; *(u32x4*)(fg + 2048 + ks2 * 1024) = fr; *(u32x4*)(fg + 4096 + ks2 * 1024) = fb; *(u32x4*)(fg + 6144 + ks2 * 1024) = fk; }
            }
            rks += __shfl_xor(rks, 16); rks += __shfl_xor(rks, 32);
            {
                const size_t pi = (size_t)u * NH + hh;
                LDS_WAIT();
#pragma unroll
                for (int kb = 0; kb < 4; ++kb) { const u32x4 val = *(const LAS u32x4*)(scr + (kb * 64 + lane) * 16); *(u32x4*)(F.ws + WS_CBK + pi * 4096 + (size_t)(kb * 64 + lane) * 16) = val; }
                LDS_WAIT();
            }
            if (q == 0) rk[(size_t)m * NH + hh] = rks;
        }
    }
    asm volatile("s_waitcnt vmcnt(0)" ::: "memory");
    for (int rep11 = 0; rep11 < NREP(11); ++rep11)
    for (int u = F.bid; u < M / 16; u += F.G) {
#pragma unroll 1
        for (int hh2 = 0; hh2 < 2; ++hh2) {
            int lane = F.lane; asm volatile("" : "+v"(lane));
            chunk_tail(F.lds + F.wave * PSCR, lane, F.ws, (size_t)u * NH + F.wave * 2 + hh2, sV + (size_t)(u * 16) * RW + (F.wave * 2 + hh2) * 64);
        }
    }
}

#define SQ_BAR() asm volatile("s_waitcnt lgkmcnt(0)\n\ts_barrier" ::: "memory")
constexpr int SQ_SLOT = 15 * 1024, SQ_RC = 4, SQ_BUF = SQ_RC * SQ_SLOT, SQ_NR = (SEQ / 16) / SQ_RC;
__device__ __forceinline__ void phase_scan(const Args& A, Ctx& F, int l) {
    F.refresh();
    (void)A; (void)l;
    float* o = (float*)(F.ws + WS_HM);
    const int lane = F.lane, wv = F.wave, q = lane >> 4;
    for (int u = F.bid; u < 256; u += F.G) {
        const int vs = u & 3, h = (u >> 2) & 15, b = u >> 6;
        const size_t pi0 = (size_t)(b * (SEQ / 16)) * NH + h;
        __syncthreads();
        if (wv >= 1 && wv <= 5) {
            const unsigned char* pb[3]; unsigned sb[3];
#pragma unroll
            for (int j = 0; j < 3; ++j) { const int id = 3 * (wv - 1) + j;
                if (id < 2)       { pb[j] = F.ws + WS_CW1 + pi0 * 2048 + (size_t)id * 1024 + lane * 16; sb[j] = 16 * 2048; }
                else if (id < 4)  { pb[j] = F.ws + WS_CR2 + pi0 * 2048 + (size_t)(id - 2) * 1024 + lane * 16; sb[j] = 16 * 2048; }
                else if (id < 8)  { pb[j] = F.ws + WS_CBK + pi0 * 4096 + (size_t)(id - 4) * 1024 + lane * 16; sb[j] = 16 * 4096; }
                else if (id < 12) { pb[j] = F.ws + WS_CPC + pi0 * 256 + (size_t)(16 * (id - 8) + 4 * q) * 4; sb[j] = 16 * 256; }
                else              { pb[j] = F.ws + (id == 12 ? WS_CU0 : (id == 13 ? WS_CY0 : WS_CVO)) + pi0 * 4096 + (size_t)vs * 1024 + lane * 16; sb[j] = 16 * 4096; } }
            u32x4 rs[3][SQ_RC][3];
#define SQ_LOAD(set, rnd) do { _Pragma("unroll") for (int i_ = 0; i_ < SQ_RC; ++i_) { int ch_ = (rnd) * SQ_RC + i_; ch_ = ch_ < SEQ / 16 ? ch_ : SEQ / 16 - 1; \
            _Pragma("unroll") for (int j_ = 0; j_ < 3; ++j_) rs[set][i_][j_] = *(const u32x4*)(pb[j_] + (size_t)ch_ * sb[j_]); } } while (0)
#define SQ_STORE(set, bufi) do { _Pragma("unroll") for (int i_ = 0; i_ < SQ_RC; ++i_) _Pragma("unroll") for (int j_ = 0; j_ < 3; ++j_) \
            *(LAS u32x4*)(F.lds + (bufi) * SQ_BUF + i_ * SQ_SLOT + (3 * (wv - 1) + j_) * 1024 + lane * 16) = rs[set][i_][j_]; } while (0)
            SQ_LOAD(0, 0); SQ_LOAD(1, 1); SQ_LOAD(2, 2);
            SQ_STORE(0, 0); SQ_LOAD(0, 3);
            SQ_BAR();
            for (int r0 = 0; r0 < SQ_NR + 1; r0 += 3) {
#pragma unroll
                for (int s3 = 0; s3 < 3; ++s3) { const int r = r0 + s3;
                    if (r < SQ_NR + 1) {
                        SQ_STORE((s3 + 1) % 3, (r + 1) & 1); SQ_LOAD((s3 + 1) % 3, r + 4);
                        SQ_BAR(); } }
            }
#undef SQ_LOAD
#undef SQ_STORE
        } else if (wv == 0) {
            f32x4 ST[4];
#pragma unroll
            for (int kb = 0; kb < 4; ++kb) ST[kb] = (f32x4){0.f, 0.f, 0.f, 0.f};
            float* orow = o + ((size_t)b * SEQ + 4 * q) * RW + h * 64 + vs * 16 + (lane & 15);
            SQ_BAR();
            for (int r = 0; r < SQ_NR + 1; ++r) {
                if (r < SQ_NR) {
                    bf16x8 W1[2][2], R2[2][2], BK[2][4]; f32x4 PC[2][4], U0[2], Y0[2], VO[2];
#define SQ_LDOPS(pp, ci) do { const LAS unsigned char* sl_ = F.lds + (r & 1) * SQ_BUF + (ci) * SQ_SLOT + lane * 16; \
                        _Pragma("unroll") for (int k2 = 0; k2 < 2; ++k2) { W1[pp][k2] = *(const LAS bf16x8*)(sl_ + k2 * 1024); R2[pp][k2] = *(const LAS bf16x8*)(sl_ + (2 + k2) * 1024); } \
                        _Pragma("unroll") for (int kb = 0; kb < 4; ++kb) { BK[pp][kb] = *(const LAS bf16x8*)(sl_ + (4 + kb) * 1024); PC[pp][kb] = *(const LAS f32x4*)(sl_ + (8 + kb) * 1024); } \
                        U0[pp] = *(const LAS f32x4*)(sl_ + 12 * 1024); Y0[pp] = *(const LAS f32x4*)(sl_ + 13 * 1024); VO[pp] = *(const LAS f32x4*)(sl_ + 14 * 1024); } while (0)
                    SQ_LDOPS(0, 0);
#pragma unroll
                    for (int i = 0; i < SQ_RC; ++i) {
                        const int pp = i & 1;
                        if (i + 1 < SQ_RC) SQ_LDOPS((i + 1) & 1, i + 1);
                        bf16x8 SB[2];
#pragma unroll
                        for (int k2 = 0; k2 < 2; ++k2) { u32x4 w; w.x = cvtpk(ST[2 * k2][0], ST[2 * k2][1]); w.y = cvtpk(ST[2 * k2][2], ST[2 * k2][3]);
                            w.z = cvtpk(ST[2 * k2 + 1][0], ST[2 * k2 + 1][1]); w.w = cvtpk(ST[2 * k2 + 1][2], ST[2 * k2 + 1][3]); SB[k2] = __builtin_bit_cast(bf16x8, w); }
                        f32x4 X = __builtin_amdgcn_mfma_f32_16x16x32_bf16(W1[pp][0], SB[0], U0[pp], 0, 0, 0); X = __builtin_amdgcn_mfma_f32_16x16x32_bf16(W1[pp][1], SB[1], X, 0, 0, 0);
                        f32x4 Yv = __builtin_amdgcn_mfma_f32_16x16x32_bf16(R2[pp][0], SB[0], Y0[pp], 0, 0, 0); Yv = __builtin_amdgcn_mfma_f32_16x16x32_bf16(R2[pp][1], SB[1], Yv, 0, 0, 0);
                        u32x4 uvw; uvw.x = cvtpk(X[0], X[1]); uvw.y = cvtpk(X[2], X[3]); uvw.z = cvtpk(VO[pp][0], VO[pp][1]); uvw.w = cvtpk(VO[pp][2], VO[pp][3]);
                        const bf16x8 UV = __builtin_bit_cast(bf16x8, uvw);
#pragma unroll
                        for (int kb = 0; kb < 4; ++kb) ST[kb] = __builtin_amdgcn_mfma_f32_16x16x32_bf16(BK[pp][kb], UV, ST[kb] * PC[pp][kb], 0, 0, 0);
                        float* op = orow + (size_t)((r * SQ_RC + i) * 16) * RW;
#pragma unroll
                        for (int j = 0; j < 4; ++j) op[(size_t)j * RW] = Yv[j];
                    }
#undef SQ_LDOPS
                }
                SQ_BAR();
            }
        } else {
            SQ_BAR();
            for (int r = 0; r < SQ_NR + 1; ++r) SQ_BAR();
        }
    }
    __syncthreads();
}

__device__ __forceinline__ void phase_post(const Args& A, Ctx& F, int l) {
    F.refresh();
    const int gw = F.bid * NWAVES + F.wave, NGW = F.G * NWAVES, lane = F.lane;
    const float* o = (const float*)(F.ws + WS_HM); const float* sV = (const float*)(F.ws + (l == 0 ? WS_V0 : WS_V1)); const float* rk = (const float*)(F.ws + WS_RK);
    const bf16_t* proj = (const bf16_t*)(F.ws + WS_PROJ); bf16_t* yb = (bf16_t*)(F.ws + WS_YB);
    const float* lg = A.in[20] + l * RW + 16 * lane; const float* lb = A.in[21] + l * RW + 16 * lane; const float* mu = A.in[8] + (size_t)l * 4224 + 3072 + 16 * lane;
    f32x4 g4[4], b4[4], mu4[4];
#pragma unroll
    for (int j = 0; j < 4; ++j) { g4[j] = *(const f32x4*)(lg + 4 * j); b4[j] = *(const f32x4*)(lb + 4 * j); mu4[j] = *(const f32x4*)(mu + 4 * j); }
    const u32x4 zero4 = {0u, 0u, 0u, 0u};
    f32x4 on[4], vn[4]; u32x4 cn[2], pn[2]; float rkn = 0.f;
#define POST_LOAD(mm) do { const bool hp_ = ((mm) & (SEQ - 1)) != 0; const bf16_t* pr_ = proj + (size_t)(mm) * NPAD + C_ZB + 16 * lane; \
        _Pragma("unroll") for (int j = 0; j < 4; ++j) { on[j] = __builtin_nontemporal_load((const f32x4*)(o + (size_t)(mm) * RW + 16 * lane + 4 * j)); vn[j] = *(const f32x4*)(sV + (size_t)(mm) * RW + 16 * lane + 4 * j); } \
        _Pragma("unroll") for (int hf = 0; hf < 2; ++hf) { cn[hf] = *(const u32x4*)(pr_ + 8 * hf); pn[hf] = hp_ ? *(const u32x4*)(pr_ - NPAD + 8 * hf) : zero4; } \
        rkn = rk[(size_t)(mm) * NH + (lane >> 2)]; } while (0)
    if (gw < M) POST_LOAD(gw);
    for (int m = gw; m < M; m += NGW) {
        f32x4 ov[4], vv[4]; u32x4 cu[2], pv[2];
#pragma unroll
        for (int j = 0; j < 4; ++j) { ov[j] = on[j]; vv[j] = vn[j]; }
        cu[0] = cn[0]; cu[1] = cn[1]; pv[0] = pn[0]; pv[1] = pn[1]; const float rkv = rkn;
        if (m + NGW < M) POST_LOAD(m + NGW);
        float s = 0.f;
#pragma unroll
        for (int j = 0; j < 4; ++j) s += (ov[j][0] + ov[j][1]) + (ov[j][2] + ov[j][3]);
        s += __shfl_xor(s, 1); s += __shfl_xor(s, 2);
        const float mean = s * (1.f / 64.f); float s2 = 0.f;
#pragma unroll
        for (int j = 0; j < 4; ++j) { ov[j] = ov[j] - mean; s2 += (ov[j][0] * ov[j][0] + ov[j][1] * ov[j][1]) + (ov[j][2] * ov[j][2] + ov[j][3] * ov[j][3]); }
        s2 += __shfl_xor(s2, 1); s2 += __shfl_xor(s2, 2);
        const float rstd = rsqrtf(s2 * (1.f / 64.f) + LNX_EPS);
#pragma unroll
        for (int hf = 0; hf < 2; ++hf) {
            float zs[8], mul[8];
#pragma unroll
            for (int i = 0; i < 4; ++i) { mul[i] = mu4[2 * hf][i]; mul[4 + i] = mu4[2 * hf + 1][i]; }
            shift8(cu[hf], pv[hf], mul, zs);
            float y[8];
#pragma unroll
            for (int jj = 0; jj < 2; ++jj) { const int j = 2 * hf + jj;
#pragma unroll
                for (int i = 0; i < 4; ++i) y[4 * jj + i] = (ov[j][i] * rstd * g4[j][i] + b4[j][i] + rkv * vv[j][i]) * silu(zs[4 * jj + i]); }
            u32x4 w; w.x = cvtpk(y[0], y[1]); w.y = cvtpk(y[2], y[3]); w.z = cvtpk(y[4], y[5]); w.w = cvtpk(y[6], y[7]);
            *(u32x4*)(yb + (size_t)m * RW + 16 * lane + 8 * hf) = w;
        }
    }
#undef POST_LOAD
}


#define XB_TMO      128
#define XB_XCNT(j)  (256  + 64 * (j))
#define XB_XSUB(j)  (1280 + 64 * (j))
#define XB_XGEN(j)  (2304 + 64 * (j))
#define XB_TOP      3328
#define XB_TOPGEN   3392
#define XCD_BAR_WORDS 3456
#define XB_SPIN_CAP (1u << 20)
__device__ __forceinline__ unsigned xb_ld(unsigned* p)              { return __hip_atomic_load(p, __ATOMIC_RELAXED, __HIP_MEMORY_SCOPE_AGENT); }
__device__ __forceinline__ unsigned xb_add(unsigned* p, unsigned v) { return __hip_atomic_fetch_add(p, v, __ATOMIC_RELAXED, __HIP_MEMORY_SCOPE_AGENT); }
__device__ __forceinline__ unsigned xb_xcc_id() { return (unsigned)__builtin_amdgcn_s_getreg((3 << 11) | 20) & 0xFu; }
#define XB_SPIN(cond, bar) do { unsigned _sp = 0; while (cond) { __builtin_amdgcn_s_sleep(1); \
    if ((++_sp & 255u) == 0u) { if (xb_ld(&(bar)[XB_TMO])) break; if (_sp > XB_SPIN_CAP) { atomicAdd(&(bar)[XB_TMO], 1u); break; } } } } while (0)
struct XcdBarrier { unsigned* bar; unsigned x; volatile LAS unsigned* st; };
__device__ __forceinline__ XcdBarrier xcd_barrier_post(unsigned* bar, volatile LAS unsigned* st) {
    XcdBarrier b; b.bar = bar; b.x = xb_xcc_id(); b.st = st;
    if (threadIdx.x == 0) (void)xb_add(&bar[XB_XCNT(b.x)], 1u);
    return b;
}
__device__ __forceinline__ void xcd_barrier_complete(unsigned* bar, unsigned x, unsigned& nloc, unsigned& nx) {
    const unsigned G = gridDim.x * gridDim.y * gridDim.z;
    unsigned sum, cnt, mine, sp = 0u;
    for (;;) {
        sum = 0u; cnt = 0u; mine = 0u;
#pragma unroll
        for (unsigned j = 0; j < 16; ++j) { const unsigned c = xb_ld(&bar[XB_XCNT(j)]); sum += c; cnt += (c > 0u) ? 1u : 0u; mine = (j == x) ? c : mine; }
        if (sum == G) break;
        __builtin_amdgcn_s_sleep(1);
        if ((++sp & 255u) == 0u) { if (xb_ld(&bar[XB_TMO])) break; if (sp > XB_SPIN_CAP) { atomicAdd(&bar[XB_TMO], 1u); break; } }
    }
    nloc = mine > 0u ? mine : 1u; nx = cnt > 0u ? cnt : 1u;
}
__device__ __forceinline__ void xcd_barrier(const XcdBarrier& b) {
    asm volatile("s_waitcnt vmcnt(0)" ::: "memory");
    __syncthreads();
    if (threadIdx.x == 0) {
        unsigned* bar = b.bar;
        __builtin_amdgcn_s_waitcnt(0);
        unsigned nloc = b.st[0], nx = b.st[1];
        if (nloc == 0u) { xcd_barrier_complete(bar, b.x, nloc, nx); b.st[0] = nloc; b.st[1] = nx; }
        const unsigned old = xb_add(&bar[XB_XSUB(b.x)], 1u);
        const unsigned gen = old / nloc;
        if (old + 1u == (gen + 1u) * nloc) {
            __builtin_amdgcn_fence(__ATOMIC_RELEASE, "agent");
            asm volatile("s_waitcnt vmcnt(0)" ::: "memory");
            const unsigned og = xb_add(&bar[XB_TOP], 1u);
            const unsigned tg = og / nx;
            if (og + 1u == (tg + 1u) * nx) xb_add(&bar[XB_TOPGEN], 1u);
            else XB_SPIN(xb_ld(&bar[XB_TOPGEN]) == tg, bar);
            __builtin_amdgcn_fence(__ATOMIC_ACQUIRE, "agent");
            xb_add(&bar[XB_XGEN(b.x)], 1u);
            asm volatile("s_waitcnt vmcnt(0)" ::: "memory");
        } else {
            XB_SPIN(xb_ld(&bar[XB_XGEN(b.x)]) == gen, bar);
            __builtin_amdgcn_fence(__ATOMIC_ACQUIRE, "agent");
            asm volatile("s_waitcnt vmcnt(0)" ::: "memory");
        }
    }
    __syncthreads();
}
constexpr size_t WS_BAR = 512 * 1024;
constexpr int LDS_ST = 8 * PSCR + 64;

__global__ void __launch_bounds__(NTHREADS, 2) mk_fwd(Args args) {
    extern __shared__ __attribute__((aligned(16))) unsigned char lds_raw[];
    Ctx F;
    F.lds = (LAS unsigned char*)lds_raw;
    F.tid = threadIdx.x; F.lane = F.tid & 63; F.wave = __builtin_amdgcn_readfirstlane(F.tid >> 6);
    F.G = gridDim.x; F.bid = blockIdx.x;
    F.out = args.out; F.ws = args.ws;
    const int lo = args.ph_lo, hi = args.ph_hi;
#if MK_COOP
    cg::grid_group grid = cg::this_grid();
    unsigned* barw = (unsigned*)(F.ws + WS_CTL + WS_BAR);
    volatile LAS unsigned* st = (volatile LAS unsigned*)(F.lds + LDS_ST);
    if (F.tid < 2) st[F.tid] = 0u;
    if (F.bid == 0) for (int i = F.tid; i < XCD_BAR_WORDS; i += NTHREADS) __hip_atomic_store(barw + i, 0u, __ATOMIC_RELAXED, __HIP_MEMORY_SCOPE_AGENT);
    __syncthreads();
    XcdBarrier xbar; xbar.bar = barw; xbar.x = 0; xbar.st = st;
#define SEAM(k) do { if (lo <= (k) && (k) + 1 < hi) { if ((k) == 0) { grid.sync(); xbar = xcd_barrier_post(barw, st); } else xcd_barrier(xbar); } } while (0)
#else
#define SEAM(k) do { } while (0)
#endif
#ifndef PHMASK
#define PHMASK 0xFFFF
#endif
#define IN(k) (lo <= (k) && (k) < hi)
#define PM(i) ((PHMASK >> (i)) & 1)

    bf16_t* WinT = (bf16_t*)(F.ws + WS_WINT);
    bf16_t* hbuf = (bf16_t*)(F.ws + WS_HM);
    bf16_t* proj = (bf16_t*)(F.ws + WS_PROJ);

    if (PM(0) && IN(0)) { for (int rep = 0; rep < NREP(0); ++rep) phase_convert(args, F); SEAM(0); }
    if (PM(1) && IN(1)) {
        for (int rep = 0; rep < NREP(1); ++rep)
        {
            const int gi = F.bid >> 3; const bool valid = F.bid < 64; const int l = gi >> 2, g = gi & 3;
            pg8::Gemm gm{(const bf16_t*)(F.ws + WS_WPOOLT) + (size_t)(valid ? gi : 0) * 65536, (const bf16_t*)(F.ws + WS_WINUA) + (size_t)(valid ? gi : 0) * DM * 256, 256, DM, 256};
            pg8::OneUnit S{valid, {0, F.bid & 7}};
            pg8::EpiBf16 E{WinT + (size_t)(valid ? l : 0) * NPAD * DM + (size_t)(valid ? g : 0) * 256 * DM, DM};
            pg8::gemm_phase<pg8::EpiBf16, pg8::OneUnit, true, true>(F.lds, gm, S, E);
        }
        if (F.G == 256) {
            if (F.bid >= 64) phase_rows(args, F, 0, (F.bid - 64) * NWAVES + F.wave, 1536, 5);
            else phase_rows(args, F, 0, 7680 + F.bid * NWAVES + F.wave, 1, 1);
        } else phase_rows(args, F, 0);
        SEAM(1);
    }
#pragma unroll 1
    for (int l = 0; l < 2; ++l) {
        const int pb = 2 + 7 * l;
        if (PM(2) && IN(pb + 0)) {
            for (int rep = 0; rep < NREP(2); ++rep) {
            pg8::Gemm gm{hbuf, WinT + (size_t)l * NPAD * DM, M, NPAD, DM}; pg8::StaticOrder S; S.init(M, NPAD, F.G, F.bid);
            pg8::EpiBf16 E{proj, NPAD};
            pg8::gemm_phase<pg8::EpiBf16, pg8::StaticOrder, true, true>(F.lds, gm, S, E); }
            SEAM(pb + 0);
        }
        if (PM(3) && IN(pb + 1)) { for (int rep = 0; rep < NREP(3); ++rep) phase_prep(args, F, l); SEAM(pb + 1); }
        if (PM(4) && IN(pb + 2)) { for (int rep = 0; rep < NREP(4); ++rep) phase_scan(args, F, l); SEAM(pb + 2); }
        if (PM(5) && IN(pb + 3)) { for (int rep = 0; rep < NREP(5); ++rep) phase_post(args, F, l); SEAM(pb + 3); }
        if (PM(6) && IN(pb + 4)) {
            for (int rep = 0; rep < NREP(6); ++rep) {
            pg8::StaticOrder S; S.init(M, DM, F.G, F.bid);
            { pg8::Gemm gm{(const bf16_t*)(F.ws + WS_YA), (const bf16_t*)(F.ws + WS_WBRA) + (size_t)l * DM * PW, M, DM, PW};
              pg8::EpiGate<false> E{hbuf, DM, proj, NPAD, C_GA};
              pg8::gemm_phase<pg8::EpiGate<false>, pg8::StaticOrder, true, true>(F.lds, gm, S, E); }
            { pg8::Gemm gm{(const bf16_t*)(F.ws + WS_YB), (const bf16_t*)(F.ws + WS_WBRB) + (size_t)l * DM * RW, M, DM, RW};
              pg8::EpiGate<true> E{hbuf, DM, proj, NPAD, C_GB};
              pg8::gemm_phase<pg8::EpiGate<true>, pg8::StaticOrder, true, true>(F.lds, gm, S, E); } }
            SEAM(pb + 4);
        }
        if (PM(7) && IN(pb + 5)) {
            for (int rep = 0; rep < NREP(7); ++rep) {
            pg8::Gemm gm{hbuf, (const bf16_t*)(F.ws + WS_WOUT) + (size_t)l * DM * DM, M, DM, DM}; pg8::StaticOrder S; S.init(M, DM, F.G, F.bid);
            pg8::EpiBf16 E{(bf16_t*)(F.ws + WS_OUTF), DM};
            pg8::gemm_phase<pg8::EpiBf16, pg8::StaticOrder, true, true>(F.lds, gm, S, E); }
            SEAM(pb + 5);
        }
        if (PM(8) && IN(pb + 6)) { phase_rows(args, F, l + 1); SEAM(pb + 6); }
    }
#undef IN
#undef SEAM
}

extern "C" void kernel_launch(void* const* d_in, const int* in_sizes, int n_in, void* d_out, int out_size, void* d_ws, size_t ws_size, hipStream_t stream) {
    static int grid = 0;
    if (grid == 0) {
        if (n_in != 26 || out_size != M * DM || ws_size < WS_END) { fprintf(stderr, "kernel_launch: unexpected shapes (n_in %d, out %d, ws %zu < %zu)\n", n_in, out_size, ws_size, (size_t)WS_END); grid = -1; return; }
        int dev = 0, cus = 0, per_cu = 0;
        if (hipGetDevice(&dev) != hipSuccess || hipDeviceGetAttribute(&cus, hipDeviceAttributeMultiprocessorCount, dev) != hipSuccess) { grid = -1; return; }
        if (hipFuncSetAttribute((const void*)mk_fwd, hipFuncAttributeMaxDynamicSharedMemorySize, LDS_BYTES) != hipSuccess) { fprintf(stderr, "kernel_launch: hipFuncSetAttribute failed\n"); grid = -1; return; }
        if (hipOccupancyMaxActiveBlocksPerMultiprocessor(&per_cu, (const void*)mk_fwd, NTHREADS, LDS_BYTES) != hipSuccess || per_cu < 1) { fprintf(stderr, "kernel_launch: occupancy query gave %d\n", per_cu); (void)hipGetLastError(); per_cu = 1; }
        grid = cus * per_cu;
        if (grid > 256) grid = 256;
    }
    if (grid < 0) return;
    Args a{};
    for (int i = 0; i < 26; ++i) a.in[i] = (const float*)d_in[i];
    a.out = (float*)d_out; a.ws = (unsigned char*)d_ws;
#if MK_COOP
    a.ph_lo = 0; a.ph_hi = NPHASES;
    void* kargs[] = {&a};
    hipError_t e = hipLaunchCooperativeKernel((const void*)mk_fwd, dim3(grid), dim3(NTHREADS), kargs, LDS_BYTES, stream);
    if (e != hipSuccess) fprintf(stderr, "cooperative launch failed: %s (grid %d)\n", hipGetErrorString(e), grid);
#else
    for (int p = 0; p < NPHASES; ++p) {
        a.ph_lo = p; a.ph_hi = p + 1;
        hipLaunchKernelGGL(mk_fwd, dim3(grid), dim3(NTHREADS), LDS_BYTES, stream, a);
    }
#endif
}
```

```cpp
#include <hip/hip_runtime.h>
#include <hip/hip_cooperative_groups.h>
#include <cstdio>
#include <cstdint>
namespace cg = cooperative_groups;

#ifndef MK_COOP
#define MK_COOP 1
#endif

#ifndef REPMASK
#define REPMASK 0
#endif
#define NREP(i) (1 + ((REPMASK >> (i)) & 1))
#define LAS __attribute__((address_space(3)))
typedef unsigned short bf16_t;
typedef short bf16x8 __attribute__((ext_vector_type(8)));
typedef float f32x4 __attribute__((ext_vector_type(4)));
typedef float f32x2 __attribute__((ext_vector_type(2)));
typedef unsigned u32x4 __attribute__((ext_vector_type(4)));
typedef unsigned u32x2 __attribute__((ext_vector_type(2)));

#define LDS_WAIT() asm volatile("s_waitcnt lgkmcnt(0)" ::: "memory")

__device__ __forceinline__ unsigned f2bf(float f) { unsigned u = __builtin_bit_cast(unsigned, f); return (u + 0x7fffu + ((u >> 16) & 1u)) >> 16; }
__device__ __forceinline__ unsigned pk2(float lo, float hi) { return f2bf(lo) | (f2bf(hi) << 16); }
typedef __bf16 bf16x2_t __attribute__((ext_vector_type(2)));
__device__ __forceinline__ unsigned cvtpk(float lo, float hi) { const f32x2 v = {lo, hi}; const bf16x2_t b = __builtin_convertvector(v, bf16x2_t); return __builtin_bit_cast(unsigned, b); }
__device__ __forceinline__ float bflo(unsigned u) { return __builtin_bit_cast(float, u << 16); }
__device__ __forceinline__ float bfhi(unsigned u) { return __builtin_bit_cast(float, u & 0xffff0000u); }
__device__ __forceinline__ float sigm(float x) { return __builtin_amdgcn_rcpf(1.f + __expf(-x)); }
__device__ __forceinline__ float silu(float x) { return x * __builtin_amdgcn_rcpf(1.f + __expf(-x)); }
__device__ __forceinline__ float tanh_(float x) { return 1.f - 2.f * __builtin_amdgcn_rcpf(__expf(2.f * x) + 1.f); }
__device__ __forceinline__ float softplus_(float x) { return fmaxf(x, 0.f) + __logf(1.f + __expf(-fabsf(x))); }

constexpr int DM = 2048, NBATCH = 4, SEQ = 2048, M = NBATCH * SEQ;
constexpr int PW = 1024, RW = 1024, NH = 16, HD = 64;
constexpr int NIN = 10368, NPAD = 10496;
constexpr int C_ZA = 1024, C_R = 2048, C_K = 3072, C_V = 4096, C_ZB = 5120, C_WLO = 6144, C_ALO = 6208, C_GA = 6272, C_GB = 8320, C_MV = 10368;
constexpr float RMS_EPS = 1e-6f, LNX_EPS = 64e-5f;

namespace pg8 {
constexpr int BM = 256, BK = 64, HALF = 128, HTB = HALF * BK * 2, NXCD = 8, WGM = 8;
__host__ __device__ __forceinline__ int lds_byte(int r, int c) { const int st = (r >> 4) * 2 + (c >> 5), rr = r & 15, cc = c & 31, ob = rr * 64 + cc * 2; return st * 1024 + (ob ^ (((ob >> 9) & 1) << 5)); }
__host__ __device__ __forceinline__ void stage_rc(int b, int& R, int& C) { const int st = b / 1024, sb = b % 1024, swz = sb ^ (((sb >> 9) & 1) << 5); R = (st >> 1) * 16 + swz / 64; C = (st & 1) * 32 + (swz % 64) / 2; }
__host__ __device__ __forceinline__ int perm32(int rho) { const int n = rho >> 4, i = rho & 15; return 8 * (i >> 2) + 4 * n + (i & 3); }

struct Unit { int pm, pn; };
struct Gemm { const bf16_t* A; const bf16_t* Bt; int M, N, K; };

struct StaticOrder {
    int nM, nN, nwg, G, c;
    __device__ void init(int M_, int N_, int G_, int c_) { nM = M_ / BM; nN = N_ / BM; nwg = nM * nN; G = G_; c = c_; }
    __device__ bool next(int i, Unit& u) const {
        const long L = (long)i * G + c; if (L >= nwg) return false;
        int wgid = (int)L; { const int q = nwg / NXCD, r = nwg % NXCD, xcd = wgid % NXCD, off = wgid / NXCD; wgid = (xcd < r ? xcd * (q + 1) : r * (q + 1) + (xcd - r) * q) + off; }
        const int nig = WGM * nN, gid = wgid / nig, fm = gid * WGM, gsz = (nM - fm) < WGM ? (nM - fm) : WGM;
        u.pm = fm + ((wgid % nig) % gsz); u.pn = (wgid % nig) / gsz; return true;
    }
    __device__ __forceinline__ void a_ready(const Unit&) const {}
    __device__ __forceinline__ void done(const Unit&) const {}
};
struct OneUnit {
    bool valid; Unit u;
    __device__ bool next(int i, Unit& o) const { if (i != 0 || !valid) return false; o = u; return true; }
    __device__ __forceinline__ void a_ready(const Unit&) const {}
    __device__ __forceinline__ void done(const Unit&) const {}
};

__device__ __forceinline__ unsigned cvt_pk_bf16(float lo, float hi) { unsigned r; asm volatile("v_cvt_pk_bf16_f32 %0, %1, %2" : "=v"(r) : "v"(lo), "v"(hi)); return r; }

struct EpiBf16 {
    static constexpr bool PERM = true, AFTER_DRAIN = false;
    bf16_t* O; int ldc;
    __device__ __forceinline__ void operator()(const f32x4 (&acc)[2][2][4][2], const Unit& u, int wr, int wc, int fr, int fq) const {
        const int row0 = u.pm * BM + wr * 64 + fr, col0 = u.pn * BM + wc * 32 + 8 * fq;
#pragma unroll
        for (int ai = 0; ai < 2; ++ai)
#pragma unroll
            for (int m = 0; m < 4; ++m) { bf16_t* rowp = O + (size_t)(row0 + ai * HALF + m * 16) * ldc + col0;
#pragma unroll
                for (int bj = 0; bj < 2; ++bj) { const f32x4 v0 = acc[ai][bj][m][0], v1 = acc[ai][bj][m][1];
                    u32x4 w; w.x = cvt_pk_bf16(v0[0], v0[1]); w.y = cvt_pk_bf16(v0[2], v0[3]); w.z = cvt_pk_bf16(v1[0], v1[1]); w.w = cvt_pk_bf16(v1[2], v1[3]);
                    *(u32x4*)(rowp + bj * HALF) = w; } }
    }
};
template <bool ACCUM> struct EpiGate {
    static constexpr bool PERM = true, AFTER_DRAIN = false;
    bf16_t* O; int ldc; const bf16_t* G; int ldg; int gcol;
    __device__ __forceinline__ void operator()(const f32x4 (&acc)[2][2][4][2], const Unit& u, int wr, int wc, int fr, int fq) const {
        const int row0 = u.pm * BM + wr * 64 + fr, col0 = u.pn * BM + wc * 32 + 8 * fq;
#pragma unroll
        for (int ai = 0; ai < 2; ++ai)
#pragma unroll
            for (int m = 0; m < 4; m += 2) {
                u32x4 g[2][2], p[2][2];
#pragma unroll
                for (int mm = 0; mm < 2; ++mm) { const int row = row0 + ai * HALF + (m + mm) * 16; const bf16_t* gp = G + (size_t)row * ldg + gcol + col0; const bf16_t* rowp = O + (size_t)row * ldc + col0;
#pragma unroll
                    for (int bj = 0; bj < 2; ++bj) { g[mm][bj] = *(const u32x4*)(gp + bj * HALF); if (ACCUM) p[mm][bj] = *(const u32x4*)(rowp + bj * HALF); } }
#pragma unroll
                for (int mm = 0; mm < 2; ++mm) { const int row = row0 + ai * HALF + (m + mm) * 16; bf16_t* rowp = O + (size_t)row * ldc + col0;
#pragma unroll
                    for (int bj = 0; bj < 2; ++bj) { const f32x4 v0 = acc[ai][bj][m + mm][0], v1 = acc[ai][bj][m + mm][1]; const u32x4 gg = g[mm][bj];
                        float o[8];
                        o[0] = sigm(bflo(gg.x)) * v0[0]; o[1] = sigm(bfhi(gg.x)) * v0[1]; o[2] = sigm(bflo(gg.y)) * v0[2]; o[3] = sigm(bfhi(gg.y)) * v0[3];
                        o[4] = sigm(bflo(gg.z)) * v1[0]; o[5] = sigm(bfhi(gg.z)) * v1[1]; o[6] = sigm(bflo(gg.w)) * v1[2]; o[7] = sigm(bfhi(gg.w)) * v1[3];
                        if (ACCUM) { const u32x4 pp = p[mm][bj];
                            o[0] += bflo(pp.x); o[1] += bfhi(pp.x); o[2] += bflo(pp.y); o[3] += bfhi(pp.y); o[4] += bflo(pp.z); o[5] += bfhi(pp.z); o[6] += bflo(pp.w); o[7] += bfhi(pp.w); }
                        u32x4 w; w.x = cvt_pk_bf16(o[0], o[1]); w.y = cvt_pk_bf16(o[2], o[3]); w.z = cvt_pk_bf16(o[4], o[5]); w.w = cvt_pk_bf16(o[6], o[7]);
                        *(u32x4*)(rowp + bj * HALF) = w; } }
            }
    }
};
struct EpiF32 {
    static constexpr bool PERM = true, AFTER_DRAIN = false;
    float* O; int ldc;
    __device__ __forceinline__ void operator()(const f32x4 (&acc)[2][2][4][2], const Unit& u, int wr, int wc, int fr, int fq) const {
        const int row0 = u.pm * BM + wr * 64 + fr, col0 = u.pn * BM + wc * 32 + 8 * fq;
#pragma unroll
        for (int ai = 0; ai < 2; ++ai)
#pragma unroll
            for (int m = 0; m < 4; ++m) { float* rowp = O + (size_t)(row0 + ai * HALF + m * 16) * ldc + col0;
#pragma unroll
                for (int bj = 0; bj < 2; ++bj) { *(f32x4*)(rowp + bj * HALF) = acc[ai][bj][m][0]; *(f32x4*)(rowp + bj * HALF + 4) = acc[ai][bj][m][1]; } }
    }
};

template <class Epi, class Sched, bool ALIGN_EPI = false, bool SP2 = false>
__device__ __forceinline__ void gemm_phase(LAS unsigned char* lds, const Gemm g, const Sched& S, const Epi& E) {
    int tid_ = threadIdx.x; asm volatile("" : "+v"(tid_));
    const int tid = tid_, wid = __builtin_amdgcn_readfirstlane(tid >> 6), lane = tid & 63, wr = wid >> 2, wc = wid & 3, fr = lane & 15, fq = lane >> 4;
    const int K = g.K, nt = K / BK;
    unsigned voffA[2], voffB[2];
#pragma unroll
    for (int i = 0; i < 2; ++i) { int R, C; stage_rc(tid * 16 + i * 8192, R, C); const int Rb = Epi::PERM ? ((R & ~31) + perm32(R & 31)) : R;
        voffA[i] = (unsigned)(R * K + C) * 2u; voffB[i] = (unsigned)(Rb * K + C) * 2u; }
    const size_t kstep = (size_t)(BK * 2);
    const size_t hstep = (size_t)HALF * K * 2;
    const size_t tstep = 2 * hstep;
    const unsigned ldsw = (unsigned)wid * 1024u;
    const int aoff = lds_byte(wr * 64 + fr, fq * 8), boff = lds_byte(wc * 32 + fr, fq * 8);
#define PG8_SA(b, h) (((b) * 2 + (h)) * HTB)
#define PG8_SB(b, h) ((4 + (b) * 2 + (h)) * HTB)
#define PG8_STAGE(bufoff, gbase, voff) do { _Pragma("unroll") for (int _i = 0; _i < 2; ++_i) \
        __builtin_amdgcn_global_load_lds((const unsigned*)((const char*)(gbase) + (voff)[_i]), (LAS unsigned*)(lds + (bufoff) + ldsw + _i * 8192), 16, 0, 0); } while (0)
#define PG8_LDA(dst, b, h) do { _Pragma("unroll") for (int m = 0; m < 4; ++m) _Pragma("unroll") for (int k = 0; k < 2; ++k) dst[m][k] = *(const LAS bf16x8*)(lds + PG8_SA(b, h) + aoff + m * 2048 + k * 1024); } while (0)
#define PG8_LDB(dst, b, h) do { _Pragma("unroll") for (int n = 0; n < 2; ++n) _Pragma("unroll") for (int k = 0; k < 2; ++k) dst[n][k] = *(const LAS bf16x8*)(lds + PG8_SB(b, h) + boff + n * 2048 + k * 1024); } while (0)
#define PG8_MMA(ai, bj, At, Bt) do { __builtin_amdgcn_s_setprio(1); _Pragma("unroll") for (int m = 0; m < 4; ++m) _Pragma("unroll") for (int n = 0; n < 2; ++n) _Pragma("unroll") for (int k = 0; k < 2; ++k) \
        acc[ai][bj][m][n] = __builtin_amdgcn_mfma_f32_16x16x32_bf16(Bt[n][k], At[m][k], acc[ai][bj][m][n], 0, 0, 0); __builtin_amdgcn_s_setprio(0); } while (0)
#define PG8_WAIT_V(n) asm volatile("s_waitcnt vmcnt(" #n ")" ::: "memory")
#define PG8_WAIT_L(n) asm volatile("s_waitcnt lgkmcnt(" #n ")" ::: "memory")
#define PG8_BAR __builtin_amdgcn_s_barrier()
#define PG8_SCHED __builtin_amdgcn_sched_barrier(0)
    Unit cur, nxt; int ui = 0;
    if (!S.next(0, cur)) return;
    f32x4 acc[2][2][4][2];
#pragma unroll
    for (int a = 0; a < 2; ++a)
#pragma unroll
        for (int b = 0; b < 2; ++b)
#pragma unroll
            for (int m = 0; m < 4; ++m)
#pragma unroll
                for (int n = 0; n < 2; ++n) acc[a][b][m][n] = (f32x4){0.f, 0.f, 0.f, 0.f};
    bf16x8 At[4][2], B0[2][2], B1[2][2];
    const char* cA = (const char*)g.A + (size_t)cur.pm * tstep; const char* cB = (const char*)g.Bt + (size_t)cur.pn * tstep;
    S.a_ready(cur);
    if constexpr (SP2) {
        PG8_STAGE(PG8_SB(0, 0), cB, voffB); PG8_STAGE(PG8_SB(0, 1), cB + hstep, voffB); PG8_STAGE(PG8_SA(0, 0), cA, voffA); PG8_STAGE(PG8_SA(0, 1), cA + hstep, voffA);
        if (wr == 1) PG8_BAR;
        PG8_WAIT_V(2); PG8_BAR;
        PG8_STAGE(PG8_SB(1, 0), cB + kstep, voffB); PG8_STAGE(PG8_SA(1, 0), cA + kstep, voffA); PG8_STAGE(PG8_SB(1, 1), cB + hstep + kstep, voffB);
        PG8_WAIT_V(6); PG8_BAR;
    } else {
        PG8_STAGE(PG8_SB(0, 0), cB, voffB); PG8_STAGE(PG8_SA(0, 0), cA, voffA); PG8_STAGE(PG8_SB(0, 1), cB + hstep, voffB); PG8_STAGE(PG8_SA(0, 1), cA + hstep, voffA);
        if (wr == 1) PG8_BAR;
        PG8_WAIT_V(4); PG8_BAR;
        PG8_STAGE(PG8_SB(1, 0), cB + kstep, voffB); PG8_STAGE(PG8_SA(1, 0), cA + kstep, voffA); PG8_STAGE(PG8_SB(1, 1), cB + hstep + kstep, voffB);
        PG8_WAIT_V(6); PG8_BAR;
    }
    for (;;) {
        const bool has_next = S.next(ui + 1, nxt);
        const char* nA = has_next ? (const char*)g.A + (size_t)nxt.pm * tstep : cA; const char* nB = has_next ? (const char*)g.Bt + (size_t)nxt.pn * tstep : cB;
        for (int t = 0; t < nt; t += 2) {
            const bool last = (t == nt - 2);
            const char* a1 = cA + (size_t)(t + 1) * kstep;
            const char* a2 = last ? nA : cA + (size_t)(t + 2) * kstep; const char* b2 = last ? nB : cB + (size_t)(t + 2) * kstep;
            const char* a3 = a2 + kstep; const char* b3 = b2 + kstep;
            if (last && has_next) S.a_ready(nxt);
            if constexpr (SP2) {
            PG8_LDB(B0, 0, 0); PG8_LDB(B1, 0, 1); PG8_SCHED; PG8_LDA(At, 0, 0); PG8_STAGE(PG8_SA(1, 1), a1 + hstep, voffA);
            PG8_WAIT_V(8); PG8_WAIT_L(0); PG8_BAR; PG8_MMA(0, 0, At, B0); PG8_MMA(0, 1, At, B1); PG8_BAR; PG8_SCHED;
            PG8_LDA(At, 0, 1); PG8_STAGE(PG8_SB(0, 0), b2, voffB); PG8_STAGE(PG8_SB(0, 1), b2 + hstep, voffB); PG8_STAGE(PG8_SA(0, 0), a2, voffA);
            PG8_WAIT_V(8); PG8_WAIT_L(0); PG8_BAR; PG8_MMA(1, 0, At, B0); PG8_MMA(1, 1, At, B1); PG8_BAR; PG8_SCHED;
            PG8_LDB(B0, 1, 0); PG8_LDB(B1, 1, 1); PG8_SCHED; PG8_LDA(At, 1, 0); PG8_STAGE(PG8_SA(0, 1), a2 + hstep, voffA);
            PG8_WAIT_V(8); PG8_WAIT_L(0); PG8_BAR; PG8_MMA(0, 0, At, B0); PG8_MMA(0, 1, At, B1); PG8_BAR; PG8_SCHED;
            PG8_LDA(At, 1, 1); PG8_STAGE(PG8_SB(1, 0), b3, voffB); PG8_STAGE(PG8_SB(1, 1), b3 + hstep, voffB); PG8_STAGE(PG8_SA(1, 0), a3, voffA);
            PG8_WAIT_V(8); PG8_WAIT_L(0); PG8_BAR; PG8_MMA(1, 0, At, B0); PG8_MMA(1, 1, At, B1); PG8_BAR; PG8_SCHED;
            } else {
            PG8_LDB(B0, 0, 0); PG8_SCHED; PG8_LDA(At, 0, 0); PG8_STAGE(PG8_SA(1, 1), a1 + hstep, voffA);
            PG8_WAIT_L(8); PG8_BAR; PG8_WAIT_L(0); PG8_MMA(0, 0, At, B0); PG8_BAR; PG8_SCHED;
            PG8_LDB(B1, 0, 1); PG8_STAGE(PG8_SB(0, 0), b2, voffB);
            PG8_BAR; PG8_WAIT_L(0); PG8_MMA(0, 1, At, B1); PG8_BAR;
            PG8_LDA(At, 0, 1); PG8_STAGE(PG8_SA(0, 0), a2, voffA);
            PG8_BAR; PG8_WAIT_L(0); PG8_MMA(1, 0, At, B0); PG8_BAR; PG8_SCHED;
            PG8_STAGE(PG8_SB(0, 1), b2 + hstep, voffB);
            PG8_WAIT_V(6); PG8_BAR; PG8_MMA(1, 1, At, B1); PG8_BAR;
            PG8_LDB(B0, 1, 0); PG8_SCHED; PG8_LDA(At, 1, 0); PG8_STAGE(PG8_SA(0, 1), a2 + hstep, voffA);
            PG8_WAIT_L(8); PG8_BAR; PG8_WAIT_L(0); PG8_MMA(0, 0, At, B0); PG8_BAR; PG8_SCHED;
            PG8_LDB(B1, 1, 1); PG8_STAGE(PG8_SB(1, 0), b3, voffB);
            PG8_BAR; PG8_WAIT_L(0); PG8_MMA(0, 1, At, B1); PG8_BAR;
            PG8_LDA(At, 1, 1); PG8_STAGE(PG8_SA(1, 0), a3, voffA);
            PG8_BAR; PG8_WAIT_L(0); PG8_MMA(1, 0, At, B0); PG8_BAR; PG8_SCHED;
            PG8_STAGE(PG8_SB(1, 1), b3 + hstep, voffB);
            PG8_WAIT_V(6); PG8_BAR; PG8_MMA(1, 1, At, B1); PG8_BAR;
            }
        }
        if constexpr (ALIGN_EPI) { if (wr == 0) PG8_BAR; }
        if constexpr (!Epi::AFTER_DRAIN) { E(acc, cur, wr, wc, fr, fq); S.done(cur); }
        if (!has_next) break;
#pragma unroll
        for (int a = 0; a < 2; ++a)
#pragma unroll
            for (int b = 0; b < 2; ++b)
#pragma unroll
                for (int m = 0; m < 4; ++m)
#pragma unroll
                    for (int n = 0; n < 2; ++n) acc[a][b][m][n] = (f32x4){0.f, 0.f, 0.f, 0.f};
        cur = nxt; cA = nA; cB = nB; ++ui;
        if constexpr (ALIGN_EPI) { if (wr == 1) PG8_BAR; }
    }
    PG8_WAIT_V(0);
    if constexpr (!ALIGN_EPI) { if (wr == 0) PG8_BAR; }
    PG8_BAR;
#undef PG8_SA
#undef PG8_SB
#undef PG8_STAGE
#undef PG8_LDA
#undef PG8_LDB
#undef PG8_MMA
#undef PG8_WAIT_V
#undef PG8_WAIT_L
#undef PG8_BAR
#undef PG8_SCHED
}
}

constexpr size_t MiB = 1u << 20;
constexpr size_t WS_CTL = 0, CTL_ZERO_BYTES = 1 * MiB;
constexpr size_t WINT_BYTES = (size_t)NPAD * DM * 2;
constexpr size_t WS_WINT = 1 * MiB;
constexpr size_t WS_WINUA = WS_WINT + 2 * WINT_BYTES;
constexpr size_t WS_WPOOLT = WS_WINUA + 8 * MiB;
constexpr size_t WS_WBRA = WS_WPOOLT + 1 * MiB;
constexpr size_t WS_WBRB = WS_WBRA + 8 * MiB;
constexpr size_t WS_WOUT = WS_WBRB + 8 * MiB;
constexpr size_t WS_WDEC = WS_WOUT + 16 * MiB;
constexpr size_t WS_WAAA = WS_WDEC + 256 * 1024;
constexpr size_t WS_WMV = WS_WAAA + 256 * 1024;
constexpr size_t WS_RK = WS_WMV + 512 * 1024;
constexpr size_t WS_HM = WS_RK + 1 * MiB;
constexpr size_t WS_PROJ = WS_HM + 32 * MiB;
constexpr size_t WS_CW1 = WS_PROJ + (size_t)M * NPAD * 2;
constexpr size_t WS_CR2 = WS_CW1 + 16 * MiB;
constexpr size_t WS_CBK = WS_CR2 + 16 * MiB;
constexpr size_t WS_CPC = WS_CBK + 32 * MiB;
constexpr size_t WS_CU0 = WS_CPC + 2 * MiB;
constexpr size_t WS_CY0 = WS_CU0 + 32 * MiB;
constexpr size_t WS_CVO = WS_CY0 + 32 * MiB;
constexpr size_t WS_CFR = WS_CVO + 32 * MiB;
constexpr size_t WS_V0 = WS_CFR + 64 * MiB;
constexpr size_t WS_V1 = WS_V0 + 32 * MiB;
constexpr size_t WS_YA = WS_V1 + 32 * MiB;
constexpr size_t WS_YB = WS_YA + 16 * MiB;
constexpr size_t WS_END = WS_YB + 16 * MiB;
constexpr size_t WS_OUTF = WS_CW1;

constexpr int LDS_BYTES = 163840, NWAVES = 8, NTHREADS = 512;
constexpr int PSCR = 20224;
constexpr int PT_ROW = 136, PT_ARR = 17 * PT_ROW;
constexpr int NPHASES = 16;

struct Args { const float* in[26]; float* out; unsigned char* ws; int ph_lo, ph_hi; };

struct Ctx {
    LAS unsigned char* lds; int tid, lane, wave, G, bid;
    __device__ __forceinline__ void refresh() { int t = threadIdx.x; asm volatile("" : "+v"(t)); tid = t; lane = t & 63; wave = __builtin_amdgcn_readfirstlane(t >> 6); }
    float* out; unsigned char* ws;
};

__device__ __forceinline__ float wave_sum(float v) {
#pragma unroll
    for (int o = 1; o < 64; o <<= 1) v += __shfl_xor(v, o);
    return v;
}

__device__ __forceinline__ void transpose_item(const float* W, int K, int N, int nstart, int nblk, bf16_t* WT, int row_off, LAS float* scr, int item, int lane) {
    const int kb = item / nblk, nb = item % nblk, k0 = 64 * kb, n0 = nstart + 64 * nb;
    const int lr = lane >> 4, lc = (lane & 15) * 4;
#pragma unroll 8
    for (int i = 0; i < 16; ++i) { const int kk = 4 * i + lr; *(LAS f32x4*)(scr + kk * 68 + lc) = __builtin_nontemporal_load((const f32x4*)(W + (size_t)(k0 + kk) * N + n0 + lc)); }
    LDS_WAIT();
    const int c = lane & 7;
#pragma unroll
    for (int j = 0; j < 8; ++j) { const int n = (lane >> 3) + 8 * j; const LAS float* s = scr + (8 * c) * 68 + n;
        u32x4 o; o.x = cvtpk(s[0 * 68], s[1 * 68]); o.y = cvtpk(s[2 * 68], s[3 * 68]); o.z = cvtpk(s[4 * 68], s[5 * 68]); o.w = cvtpk(s[6 * 68], s[7 * 68]);
        *(u32x4*)(WT + (size_t)(row_off + n0 + n) * K + k0 + 8 * c) = o; }
    LDS_WAIT();
}
__device__ __forceinline__ void transpose_item32(const float* W, int K, int N, bf16_t* WT, int row_off, LAS float* scr, int item, int lane) {
    const int k0 = 64 * item;
#pragma unroll 8
    for (int i = 0; i < 32; ++i) { const int kk = 2 * i + (lane >> 5); scr[kk * 33 + (lane & 31)] = W[(size_t)(k0 + kk) * N + (lane & 31)]; }
    LDS_WAIT();
    const int c = lane & 7;
#pragma unroll
    for (int j = 0; j < 4; ++j) { const int n = (lane >> 3) + 8 * j; const LAS float* s = scr + (8 * c) * 33 + n;
        u32x4 o; o.x = cvtpk(s[0 * 33], s[1 * 33]); o.y = cvtpk(s[2 * 33], s[3 * 33]); o.z = cvtpk(s[4 * 33], s[5 * 33]); o.w = cvtpk(s[6 * 33], s[7 * 33]);
        *(u32x4*)(WT + (size_t)(row_off + n) * K + k0 + 8 * c) = o; }
    LDS_WAIT();
}

__device__ __forceinline__ void phase_convert(const Args& A, Ctx& F) {
    F.refresh();
    LAS float* scr = (LAS float*)(F.lds + F.wave * 17408);
    const int gw = F.bid * NWAVES + F.wave, NGW = F.G * NWAVES;
    bf16_t* WinT = (bf16_t*)(F.ws + WS_WINT); bf16_t* WpoolT = (bf16_t*)(F.ws + WS_WPOOLT);
    bf16_t* Wbra = (bf16_t*)(F.ws + WS_WBRA); bf16_t* Wbrb = (bf16_t*)(F.ws + WS_WBRB); bf16_t* Wout = (bf16_t*)(F.ws + WS_WOUT);
    bf16_t* Wdec = (bf16_t*)(F.ws + WS_WDEC); bf16_t* Waaa = (bf16_t*)(F.ws + WS_WAAA); bf16_t* Wmv = (bf16_t*)(F.ws + WS_WMV);
    constexpr int I_IN = 32 * 146, I_BR = 16 * 32, I_OUT = 32 * 32, I_POOL = 4 * 4, I_LORA = 16, I_MVD = 32;
    constexpr int PER_L = I_IN + 2 * I_BR + I_OUT + 4 * I_POOL + 2 * I_LORA;
    constexpr int NITEMS = 2 * PER_L + I_MVD;
    for (int it = gw; it < NITEMS; it += NGW) {
        int r = it;
        if (r >= 2 * PER_L) { r -= 2 * PER_L; transpose_item32(A.in[13], DM, 32, WinT + (size_t)NPAD * DM, C_MV, scr, r, F.lane); continue; }
        const int l = r / PER_L; r -= l * PER_L;
        if (r < I_IN) { transpose_item(A.in[5] + (size_t)l * DM * NIN, DM, NIN, 1024, 146, WinT + (size_t)l * NPAD * DM, 0, scr, r, F.lane); continue; } r -= I_IN;
        if (r < I_BR) { transpose_item(A.in[22] + (size_t)l * PW * DM, PW, DM, 0, 32, Wbra + (size_t)l * DM * PW, 0, scr, r, F.lane); continue; } r -= I_BR;
        if (r < I_BR) { transpose_item(A.in[23] + (size_t)l * RW * DM, RW, DM, 0, 32, Wbrb + (size_t)l * DM * RW, 0, scr, r, F.lane); continue; } r -= I_BR;
        if (r < I_OUT) { transpose_item(A.in[24] + (size_t)l * DM * DM, DM, DM, 0, 32, Wout + (size_t)l * DM * DM, 0, scr, r, F.lane); continue; } r -= I_OUT;
        if (r < 4 * I_POOL) { const int g = r / I_POOL; r -= g * I_POOL;
            transpose_item(A.in[6] + (size_t)(l * 4 + g) * 65536, 256, 256, 0, 4, WpoolT + (size_t)(l * 4 + g) * 65536, 0, scr, r, F.lane); continue; } r -= 4 * I_POOL;
        if (r < I_LORA) { transpose_item(A.in[9] + (size_t)l * 64 * RW, 64, RW, 0, 16, Wdec + (size_t)l * RW * 64, 0, scr, r, F.lane); continue; } r -= I_LORA;
        transpose_item(A.in[11] + (size_t)l * 64 * RW, 64, RW, 0, 16, Waaa + (size_t)l * RW * 64, 0, scr, r, F.lane);
    }
    const int gt = F.bid * NTHREADS + F.tid, NGT = F.G * NTHREADS;
    { bf16_t* WinUa = (bf16_t*)(F.ws + WS_WINUA);
      for (int e0 = gt; e0 < 2 * DM * 256; e0 += 8 * NGT) {
          f32x4 v[8];
#pragma unroll
          for (int k8 = 0; k8 < 8; ++k8) { const int e = e0 + k8 * NGT; const int c4 = e & 255, k = (e >> 8) & 2047, l = e >> 19; const int g = c4 >> 6, c = (c4 & 63) * 4;
              if (e < 2 * DM * 256) v[k8] = __builtin_nontemporal_load((const f32x4*)(A.in[5] + ((size_t)l * DM + k) * NIN + g * 256 + c)); }
#pragma unroll
          for (int k8 = 0; k8 < 8; ++k8) { const int e = e0 + k8 * NGT; const int c4 = e & 255, k = (e >> 8) & 2047, l = e >> 19; const int g = c4 >> 6, c = (c4 & 63) * 4;
              if (e < 2 * DM * 256) { u32x2 o; o.x = cvtpk(v[k8][0], v[k8][1]); o.y = cvtpk(v[k8][2], v[k8][3]);
                  *(u32x2*)(WinUa + ((size_t)(l * 4 + g) * DM + k) * 256 + c) = o; } } } }
    { u32x4 z = {0u, 0u, 0u, 0u};
      for (int e = gt; e < 128 * DM / 8; e += NGT) *(u32x4*)(WinT + (size_t)C_MV * DM + (size_t)e * 8) = z;
      for (int e = gt; e < 96 * DM / 8; e += NGT) *(u32x4*)(WinT + (size_t)NPAD * DM + (size_t)(C_MV + 32) * DM + (size_t)e * 8) = z; }
    for (int e = gt; e < 32 * RW; e += NGT) { const int k = e & 31, n = e >> 5; Wmv[n * 32 + k] = (bf16_t)f2bf(A.in[15][(size_t)k * RW + n]); }
    __syncthreads();
    if (F.bid < 192) {
        float* mod = (float*)(F.ws + WS_CTL);
        LAS f32x4* cond = (LAS f32x4*)(F.lds);
        LAS float* red = (LAS float*)(F.lds + 32768);
        const int l = F.bid / 96, j0 = (F.bid % 96) * 64;
        for (int i = F.tid; i < DM; i += NTHREADS) { f32x4 cv; cv[0] = silu(A.in[1][i]); cv[1] = silu(A.in[1][DM + i]); cv[2] = silu(A.in[1][2 * DM + i]); cv[3] = silu(A.in[1][3 * DM + i]); cond[i] = cv; }
        __syncthreads();
        const int sub = F.lane >> 4, cl = (F.lane & 15) * 4;
        const float* w = A.in[2] + ((size_t)l * DM + F.wave * 256 + sub) * 6144 + j0 + cl;
        f32x4 a0 = {0, 0, 0, 0}, a1 = a0, a2 = a0, a3 = a0;
#pragma unroll 8
        for (int i = 0; i < 64; ++i) { const f32x4 wv = __builtin_nontemporal_load((const f32x4*)(w + (size_t)(4 * i) * 6144)); const f32x4 cv = cond[F.wave * 256 + 4 * i + sub];
            a0 += wv * cv[0]; a1 += wv * cv[1]; a2 += wv * cv[2]; a3 += wv * cv[3]; }
#pragma unroll
        for (int i = 0; i < 4; ++i) {
            a0[i] += __shfl_xor(a0[i], 16); a0[i] += __shfl_xor(a0[i], 32); a1[i] += __shfl_xor(a1[i], 16); a1[i] += __shfl_xor(a1[i], 32);
            a2[i] += __shfl_xor(a2[i], 16); a2[i] += __shfl_xor(a2[i], 32); a3[i] += __shfl_xor(a3[i], 16); a3[i] += __shfl_xor(a3[i], 32); }
        if (sub == 0) { *(LAS f32x4*)(red + (F.wave * 4 + 0) * 64 + cl) = a0; *(LAS f32x4*)(red + (F.wave * 4 + 1) * 64 + cl) = a1;
                        *(LAS f32x4*)(red + (F.wave * 4 + 2) * 64 + cl) = a2; *(LAS f32x4*)(red + (F.wave * 4 + 3) * 64 + cl) = a3; }
        __syncthreads();
        if (F.tid < 256) { const int b = F.tid >> 6, jj = F.tid & 63; float sacc = 0.f;
#pragma unroll
            for (int wv = 0; wv < 8; ++wv) sacc += red[(wv * 4 + b) * 64 + jj];
            mod[(size_t)(l * 4 + b) * 6144 + j0 + jj] = sacc + A.in[3][(size_t)l * 6144 + j0 + jj]; }
        __syncthreads();
    }
}

__device__ __forceinline__ void phase_rows(const Args& A, Ctx& F, int mode, int first = -1, int stride = 0, int count = 0) {
    F.refresh();
    { const int gw_ = F.bid * NWAVES + F.wave, NGW_ = F.G * NWAVES; if (first < 0) { first = gw_; stride = NGW_; count = (M - 1 - gw_) / NGW_ + 1; } }
    const int mend = first + count * stride;
    const float* mod = (const float*)(F.ws + WS_CTL);
    const bf16_t* outb = (const bf16_t*)(F.ws + WS_OUTF);
    bf16_t* hbuf = (bf16_t*)(F.ws + WS_HM);
    const int lprev = (mode == 2) ? 1 : 0;
    const int lnext = (mode == 0) ? 0 : 1;
    const float* xsrc = (mode == 2) ? F.out : A.in[0];
    f32x4 xn[8]; u32x2 on[8];
#define ROWS_LOAD(mm) do { _Pragma("unroll") for (int j = 0; j < 8; ++j) { xn[j] = *(const f32x4*)(xsrc + (size_t)(mm) * DM + j * 256 + F.lane * 4); \
        if (mode != 0) on[j] = *(const u32x2*)(outb + (size_t)(mm) * DM + j * 256 + F.lane * 4); } } while (0)
    if (count > 0) ROWS_LOAD(first);
    for (int m = first; m < mend; m += stride) {
        const int b = m >> 11;
        f32x4 xv[8]; u32x2 ob[8];
#pragma unroll
        for (int j = 0; j < 8; ++j) { xv[j] = xn[j]; ob[j] = on[j]; }
        if (m + stride < mend) ROWS_LOAD(m + stride);
        if (mode != 0) {
            f32x4 ov[8]; float ss = 0.f;
#pragma unroll
            for (int j = 0; j < 8; ++j) { ov[j] = (f32x4){bflo(ob[j].x), bfhi(ob[j].x), bflo(ob[j].y), bfhi(ob[j].y)};
                ss += ov[j][0] * ov[j][0] + ov[j][1] * ov[j][1] + ov[j][2] * ov[j][2] + ov[j][3] * ov[j][3]; }
            const float rs = rsqrtf(wave_sum(ss) * (1.f / DM) + RMS_EPS);
            const float* gm = mod + (size_t)(lprev * 4 + b) * 6144 + 4096; const float* gp = A.in[25] + (size_t)lprev * DM;
#pragma unroll
            for (int j = 0; j < 8; ++j) { const int c = j * 256 + F.lane * 4;
                const f32x4 gt = *(const f32x4*)(gm + c); const f32x4 gpo = *(const f32x4*)(gp + c);
                xv[j] += gt * (ov[j] * rs * gpo);
                *(f32x4*)(F.out + (size_t)m * DM + c) = xv[j]; }
        }
        if (mode != 2) {
            float ss = 0.f;
#pragma unroll
            for (int j = 0; j < 8; ++j) ss += xv[j][0] * xv[j][0] + xv[j][1] * xv[j][1] + xv[j][2] * xv[j][2] + xv[j][3] * xv[j][3];
            const float rs = rsqrtf(wave_sum(ss) * (1.f / DM) + RMS_EPS);
            const float* mm = mod + (size_t)(lnext * 4 + b) * 6144; const float* gpre = A.in[4] + (size_t)lnext * DM;
#pragma unroll
            for (int j = 0; j < 8; ++j) { const int c = j * 256 + F.lane * 4;
                const f32x4 sh = *(const f32x4*)(mm + c); const f32x4 sc = *(const f32x4*)(mm + 2048 + c); const f32x4 g = *(const f32x4*)(gpre + c);
                const f32x4 hv = (xv[j] * rs * g) * (sc + 1.f) + sh;
                u32x2 o; o.x = cvtpk(hv[0], hv[1]); o.y = cvtpk(hv[2], hv[3]);
                *(u32x2*)(hbuf + (size_t)m * DM + c) = o; }
        }
    }
#undef ROWS_LOAD
}

template <int W> __device__ __forceinline__ void ya_item(const bf16_t* proj, bf16_t* ya, const float* pscale, int m0, int tid) {
    const int c = 2 * tid; const int p0 = m0 & (SEQ - 1);
    const bf16_t* base = proj + (size_t)m0 * NPAD + c;
    float r0[W - 1 + 16], r1[W - 1 + 16];
#pragma unroll
    for (int i = 0; i < W - 1; ++i) { unsigned u = 0u; if (p0 > 0) u = *(const unsigned*)(base - (ptrdiff_t)(W - 1 - i) * NPAD); r0[i] = bflo(u); r1[i] = bfhi(u); }
#pragma unroll
    for (int i = 0; i < 16; ++i) { const unsigned u = *(const unsigned*)(base + (size_t)i * NPAD); r0[W - 1 + i] = bflo(u); r1[W - 1 + i] = bfhi(u); }
    const float ps0 = pscale[c], ps1 = pscale[c + 1];
    float s0 = 0.f, s1 = 0.f;
#pragma unroll
    for (int d = 0; d < W - 1; ++d) { s0 += r0[d]; s1 += r1[d]; }
#pragma unroll
    for (int i = 0; i < 16; ++i) {
        s0 += r0[W - 1 + i]; s1 += r1[W - 1 + i];
        if (i > 0) { s0 -= r0[i - 1]; s1 -= r1[i - 1]; }
        const int p = p0 + i; const float inv = __builtin_amdgcn_rcpf((float)((p + 1 < W) ? (p + 1) : W));
        const unsigned z = *(const unsigned*)(base + (size_t)i * NPAD + C_ZA);
        const float y0 = (s0 * inv - r0[W - 1 + i]) * ps0 * silu(bflo(z)), y1 = (s1 * inv - r1[W - 1 + i]) * ps1 * silu(bfhi(z));
        *(unsigned*)(ya + (size_t)(m0 + i) * PW + c) = cvtpk(y0, y1);
    }
}

__device__ __forceinline__ void shift8(const u32x4 cu, const u32x4 pv, const float* mu, float* o) {
    const f32x4 m0 = *(const f32x4*)mu, m1 = *(const f32x4*)(mu + 4);
    float z, p;
    z = bflo(cu.x); p = bflo(pv.x); o[0] = z + (p - z) * m0[0];  z = bfhi(cu.x); p = bfhi(pv.x); o[1] = z + (p - z) * m0[1];
    z = bflo(cu.y); p = bflo(pv.y); o[2] = z + (p - z) * m0[2];  z = bfhi(cu.y); p = bfhi(pv.y); o[3] = z + (p - z) * m0[3];
    z = bflo(cu.z); p = bflo(pv.z); o[4] = z + (p - z) * m1[0];  z = bfhi(cu.z); p = bfhi(pv.z); o[5] = z + (p - z) * m1[1];
    z = bflo(cu.w); p = bflo(pv.w); o[6] = z + (p - z) * m1[2];  z = bfhi(cu.w); p = bfhi(pv.w); o[7] = z + (p - z) * m1[3];
}
__device__ __forceinline__ bf16x8 pack8(const float* o) {
    u32x4 w; w.x = cvtpk(o[0], o[1]); w.y = cvtpk(o[2], o[3]); w.z = cvtpk(o[4], o[5]); w.w = cvtpk(o[6], o[7]);
    return __builtin_bit_cast(bf16x8, w);
}
__device__ __forceinline__ void shift4(const u32x2 cu, const u32x2 pv, const f32x4 mu, float* o) {
    float z, p;
    z = bflo(cu.x); p = bflo(pv.x); o[0] = z + (p - z) * mu[0];  z = bfhi(cu.x); p = bfhi(pv.x); o[1] = z + (p - z) * mu[1];
    z = bflo(cu.y); p = bflo(pv.y); o[2] = z + (p - z) * mu[2];  z = bfhi(cu.y); p = bfhi(pv.y); o[3] = z + (p - z) * mu[3];
}


#define DPPF(x, ctrl) __builtin_bit_cast(float, __builtin_amdgcn_update_dpp(0, __builtin_bit_cast(int, (x)), (ctrl), 0xF, 0xF, true))
__device__ __forceinline__ float scan16(float x) { x += DPPF(x, 0x111); x += DPPF(x, 0x112); x += DPPF(x, 0x114); x += DPPF(x, 0x118); return x; }
__device__ __forceinline__ float sum16(float x) { x += DPPF(x, 0xB1); x += DPPF(x, 0x4E); x += DPPF(x, 0x124); x += DPPF(x, 0x128); return x; }
__device__ __forceinline__ bf16x8 pack44(const float* lo, const float* hi) {
    u32x4 w; w.x = cvtpk(lo[0], lo[1]); w.y = cvtpk(lo[2], lo[3]); w.z = cvtpk(hi[0], hi[1]); w.w = cvtpk(hi[2], hi[3]); return __builtin_bit_cast(bf16x8, w);
}
__device__ __forceinline__ void chunk_tail(LAS unsigned char* scr, int lane, unsigned char* ws, size_t pi, const float* vbase) {
    const int i = lane & 15, q = lane >> 4;
    LAS float* Mab = (LAS float*)scr; LAS float* Mak = Mab + 256; LAS float* Mrb = Mab + 512; LAS float* Mrk = Mab + 768;
    LAS float* AtL = (LAS float*)(scr + 4096); LAS float* RtL = (LAS float*)(scr + 8192); LAS float* VL = (LAS float*)(scr + 12288);
    bf16x8 fa[2], fr[2], fb[2], fk[2];
    {   const unsigned char* fg = ws + WS_CFR + pi * 8192 + (size_t)lane * 16;
        u32x4 ua[2], ur[2];
        ua[0] = *(const u32x4*)(fg); ua[1] = *(const u32x4*)(fg + 1024); ur[0] = *(const u32x4*)(fg + 2048); ur[1] = *(const u32x4*)(fg + 3072);
        fb[0] = *(const bf16x8*)(fg + 4096); fb[1] = *(const bf16x8*)(fg + 5120); fk[0] = *(const bf16x8*)(fg + 6144); fk[1] = *(const bf16x8*)(fg + 7168);
        fa[0] = __builtin_bit_cast(bf16x8, ua[0]); fa[1] = __builtin_bit_cast(bf16x8, ua[1]); fr[0] = __builtin_bit_cast(bf16x8, ur[0]); fr[1] = __builtin_bit_cast(bf16x8, ur[1]);
#pragma unroll
        for (int ks = 0; ks < 2; ++ks) {
            *(LAS f32x4*)(AtL + i * 64 + 16 * (2 * ks) + 4 * q) = (f32x4){bflo(ua[ks].x), bfhi(ua[ks].x), bflo(ua[ks].y), bfhi(ua[ks].y)};
            *(LAS f32x4*)(AtL + i * 64 + 16 * (2 * ks + 1) + 4 * q) = (f32x4){bflo(ua[ks].z), bfhi(ua[ks].z), bflo(ua[ks].w), bfhi(ua[ks].w)};
            *(LAS f32x4*)(RtL + i * 64 + 16 * (2 * ks) + 4 * q) = (f32x4){bflo(ur[ks].x), bfhi(ur[ks].x), bflo(ur[ks].y), bfhi(ur[ks].y)};
            *(LAS f32x4*)(RtL + i * 64 + 16 * (2 * ks + 1) + 4 * q) = (f32x4){bflo(ur[ks].z), bfhi(ur[ks].z), bflo(ur[ks].w), bfhi(ur[ks].w)};
        }
#pragma unroll
        for (int ct = 0; ct < 4; ++ct) *(LAS f32x4*)(VL + i * 64 + 16 * ct + 4 * q) = *(const f32x4*)(vbase + (size_t)i * RW + 16 * ct + 4 * q);
    }
    {   f32x4 gab = {0, 0, 0, 0}, gak = gab, grb = gab, grk = gab;
#pragma unroll
        for (int ks = 0; ks < 2; ++ks) {
            gab = __builtin_amdgcn_mfma_f32_16x16x32_bf16(fa[ks], fb[ks], gab, 0, 0, 0); gak = __builtin_amdgcn_mfma_f32_16x16x32_bf16(fa[ks], fk[ks], gak, 0, 0, 0);
            grb = __builtin_amdgcn_mfma_f32_16x16x32_bf16(fr[ks], fb[ks], grb, 0, 0, 0); grk = __builtin_amdgcn_mfma_f32_16x16x32_bf16(fr[ks], fk[ks], grk, 0, 0, 0);
        }
        f32x4 mab, mak, mrb, mrk;
#pragma unroll
        for (int jj = 0; jj < 4; ++jj) { const int row = 4 * q + jj;
            mab[jj] = (i < row) ? gab[jj] : 0.f; mak[jj] = (i < row) ? gak[jj] : 0.f; mrb[jj] = (i <= row) ? grb[jj] : 0.f; mrk[jj] = (i <= row) ? grk[jj] : 0.f; }
        *(LAS f32x4*)(Mab + i * 16 + 4 * q) = mab; *(LAS f32x4*)(Mak + i * 16 + 4 * q) = mak; *(LAS f32x4*)(Mrb + i * 16 + 4 * q) = mrb; *(LAS f32x4*)(Mrk + i * 16 + 4 * q) = mrk;
    }
    LDS_WAIT();
    {   const int c = lane; f32x4 xv[4], rv[4]; LAS float* Mp = Mab; LAS float* Mq = Mrb;
#pragma unroll
        for (int g = 0; g < 4; ++g) { xv[g] = (f32x4){AtL[(4 * g) * 64 + c], AtL[(4 * g + 1) * 64 + c], AtL[(4 * g + 2) * 64 + c], AtL[(4 * g + 3) * 64 + c]};
                                      rv[g] = (f32x4){RtL[(4 * g) * 64 + c], RtL[(4 * g + 1) * 64 + c], RtL[(4 * g + 2) * 64 + c], RtL[(4 * g + 3) * 64 + c]}; }
#pragma unroll
        for (int j = 0; j < 15; ++j) { const float xj = xv[j >> 2][j & 3];
#pragma unroll
            for (int g = (j + 1) >> 2; g < 4; ++g) xv[g] += *(const LAS f32x4*)(Mp + j * 16 + 4 * g) * xj;
            asm volatile("" : "+v"(Mp), "+v"(xv[3][3])); }
#pragma unroll
        for (int j = 0; j < 16; ++j) { const float xj = xv[j >> 2][j & 3];
#pragma unroll
            for (int g = j >> 2; g < 4; ++g) rv[g] += *(const LAS f32x4*)(Mq + j * 16 + 4 * g) * xj;
            asm volatile("" : "+v"(Mq), "+v"(rv[3][3])); }
        LDS_WAIT();
        LAS bf16_t* w1s = (LAS bf16_t*)(scr + 4096); LAS bf16_t* r2s = (LAS bf16_t*)(scr + 4096 + 2048);
        const int ks = c >> 5, jj = ((c >> 4) & 1) * 4 + (c & 3), qt = (c >> 2) & 3;
#pragma unroll
        for (int ii = 0; ii < 16; ++ii) { const int idx = (ks * 64 + qt * 16 + ii) * 8 + jj; w1s[idx] = (bf16_t)cvtpk(xv[ii >> 2][ii & 3], 0.f); r2s[idx] = (bf16_t)cvtpk(rv[ii >> 2][ii & 3], 0.f); }
        LDS_WAIT();
#pragma unroll
        for (int k2 = 0; k2 < 2; ++k2) {
            const u32x4 w1 = *(const LAS u32x4*)(scr + 4096 + (k2 * 64 + lane) * 16), rr = *(const LAS u32x4*)(scr + 4096 + 2048 + (k2 * 64 + lane) * 16);
            *(u32x4*)(ws + WS_CW1 + pi * 2048 + (size_t)(k2 * 64 + lane) * 16) = w1; *(u32x4*)(ws + WS_CR2 + pi * 2048 + (size_t)(k2 * 64 + lane) * 16) = rr; }
    }
    {   const int vv = lane; f32x4 vc[4], uv[4], yv[4];
        LAS float* Mab2 = Mab; LAS float* Mak2 = Mak; LAS float* Mrb2 = Mrb; LAS float* Mrk2 = Mrk;
        asm volatile("" : "+v"(Mab2), "+v"(Mak2), "+v"(Mrb2), "+v"(Mrk2));
#pragma unroll
        for (int g = 0; g < 4; ++g) { vc[g] = (f32x4){VL[(4 * g) * 64 + vv], VL[(4 * g + 1) * 64 + vv], VL[(4 * g + 2) * 64 + vv], VL[(4 * g + 3) * 64 + vv]};
                                      uv[g] = (f32x4){0.f, 0.f, 0.f, 0.f}; yv[g] = (f32x4){0.f, 0.f, 0.f, 0.f}; }
#pragma unroll
        for (int j = 0; j < 15; ++j) { const float vj = vc[j >> 2][j & 3];
#pragma unroll
            for (int g = (j + 1) >> 2; g < 4; ++g) uv[g] += *(const LAS f32x4*)(Mak2 + j * 16 + 4 * g) * vj;
            asm volatile("" : "+v"(Mak2), "+v"(uv[3][3])); }
#pragma unroll
        for (int j = 0; j < 15; ++j) { const float uj = uv[j >> 2][j & 3];
#pragma unroll
            for (int g = (j + 1) >> 2; g < 4; ++g) uv[g] += *(const LAS f32x4*)(Mab2 + j * 16 + 4 * g) * uj;
            asm volatile("" : "+v"(Mab2), "+v"(uv[3][3])); }
#pragma unroll
        for (int j = 0; j < 16; ++j) { const float uj = uv[j >> 2][j & 3], vj = vc[j >> 2][j & 3];
#pragma unroll
            for (int g = j >> 2; g < 4; ++g) yv[g] += *(const LAS f32x4*)(Mrb2 + j * 16 + 4 * g) * uj + *(const LAS f32x4*)(Mrk2 + j * 16 + 4 * g) * vj;
            asm volatile("" : "+v"(Mrb2), "+v"(Mrk2), "+v"(yv[3][3])); }
        const int vs = vv >> 4;
#pragma unroll
        for (int qt = 0; qt < 4; ++qt) { const size_t off = pi * 4096 + (size_t)(vs * 64 + qt * 16 + (vv & 15)) * 16;
            *(f32x4*)(ws + WS_CU0 + off) = uv[qt]; *(f32x4*)(ws + WS_CY0 + off) = yv[qt]; *(f32x4*)(ws + WS_CVO + off) = vc[qt]; }
    }
    LDS_WAIT();
}

__device__ __forceinline__ void phase_prep(const Args& A, Ctx& F, int l) {
    F.refresh();
    const bf16_t* proj = (const bf16_t*)(F.ws + WS_PROJ);
    bf16_t* ya = (bf16_t*)(F.ws + WS_YA);
    float* sV = (float*)(F.ws + (l == 0 ? WS_V0 : WS_V1)); const float* vfirst = (const float*)(F.ws + WS_V0);
    float* rk = (float*)(F.ws + WS_RK);
    const bf16_t* WdecT = (const bf16_t*)(F.ws + WS_WDEC) + (size_t)l * RW * 64; const bf16_t* WaaaT = (const bf16_t*)(F.ws + WS_WAAA) + (size_t)l * RW * 64;
    const bf16_t* WmvT = (const bf16_t*)(F.ws + WS_WMV);
    const float* mu = A.in[8] + (size_t)l * 4224;
    const float* w0 = A.in[10] + l * RW; const float* a0 = A.in[12] + l * RW; const float* kk_ = A.in[17] + l * RW; const float* ka_ = A.in[18] + l * RW;
    const float* rk_ = A.in[19] + l * RW; const float* mv0 = A.in[16]; const float* mumv = A.in[14];
    const float* pscale = A.in[7] + l * PW;
    for (int rep9 = 0; rep9 < NREP(9); ++rep9)
    for (int u = F.bid; u < M / 16; u += F.G) {
        const int m0 = u * 16; const int g = F.tid >> 7;
        if (g == 0) ya_item<2>(proj, ya, pscale, m0, F.tid); else if (g == 1) ya_item<4>(proj, ya, pscale, m0, F.tid);
        else if (g == 2) ya_item<8>(proj, ya, pscale, m0, F.tid); else ya_item<16>(proj, ya, pscale, m0, F.tid);
    }
    asm volatile("" ::: "memory");
    for (int rep10 = 0; rep10 < NREP(10); ++rep10)
    for (int u = F.bid; u < M / 16; u += F.G) {
        const int m0 = u * 16;
        int lane = F.lane; asm volatile("" : "+v"(lane));
        const int tk = lane & 15, q = lane >> 4;
        const int m = m0 + tk; const bool hasprev = (m & (SEQ - 1)) != 0;
        int ozu = 0; asm volatile("" : "+v"(ozu));
        const bf16_t* prow = proj + (size_t)m * NPAD; const bf16_t* pprev = prow - NPAD;
        LAS unsigned char* scr = F.lds + F.wave * PSCR;
        LAS bf16_t* tile = (LAS bf16_t*)(scr + 4096);
        {
            const bool seq0 = (m0 & (SEQ - 1)) == 0;
            u32x4 tv[13];
#pragma unroll
            for (int i = 0; i < 13; ++i) { const int e = lane + 64 * i; const int arr = e / 272, rem = e - arr * 272, row = rem >> 4, c16 = rem & 15;
                tv[i] = (u32x4){0u, 0u, 0u, 0u};
                if (e < 816 && !(row == 0 && seq0)) tv[i] = *(const u32x4*)(proj + (size_t)(m0 - 1 + row) * NPAD + C_R + arr * 1024 + F.wave * 128 + c16 * 8); }
#pragma unroll
            for (int i = 0; i < 13; ++i) { const int e = lane + 64 * i; const int arr = e / 272, rem = e - arr * 272, row = rem >> 4, c16 = rem & 15;
                if (e < 816) *(LAS u32x4*)(tile + arr * PT_ARR + row * PT_ROW + c16 * 8) = tv[i]; }
            LDS_WAIT();
        }
        bf16x8 Bw[2], Ba[2], Bm;
        const u32x4 zero4 = {0u, 0u, 0u, 0u};
#pragma unroll
        for (int ks = 0; ks < 2; ++ks) {
            float o[8];
            { const int col = C_WLO + ks * 32 + q * 8; const u32x4 cu = *(const u32x4*)(prow + col); const u32x4 pv = hasprev ? *(const u32x4*)(pprev + col) : zero4;
              shift8(cu, pv, mu + 4096 + ks * 32 + q * 8 + ozu, o);
#pragma unroll
              for (int i = 0; i < 8; ++i) o[i] = tanh_(o[i]);
              Bw[ks] = pack8(o); }
            { const int col = C_ALO + ks * 32 + q * 8; const u32x4 cu = *(const u32x4*)(prow + col); const u32x4 pv = hasprev ? *(const u32x4*)(pprev + col) : zero4;
              shift8(cu, pv, mu + 4160 + ks * 32 + q * 8 + ozu, o); Ba[ks] = pack8(o); }
        }
        if (l == 1) { float o[8]; const int col = C_MV + q * 8; const u32x4 cu = *(const u32x4*)(prow + col); const u32x4 pv = hasprev ? *(const u32x4*)(pprev + col) : zero4;
            shift8(cu, pv, mumv + q * 8 + ozu, o); Bm = pack8(o); } else Bm = (bf16x8){0, 0, 0, 0, 0, 0, 0, 0};
#pragma unroll 1
        for (int hh2 = 0; hh2 < 2; ++hh2) {
            const int hh = F.wave * 2 + hh2;
            int oz = 0; asm volatile("" : "+v"(oz));
            float ssq = 0.f, rks = 0.f;
            LAS bf16_t* bk = (LAS bf16_t*)scr;
            const LAS bf16_t* trow = tile + (tk + 1) * PT_ROW + hh2 * 64 + 4 * q;
#pragma unroll
            for (int ct = 0; ct < 4; ++ct) { const int cl = hh * 64 + ct * 16 + 4 * q + oz; float kt[4];
                const u32x2 cu = *(const LAS u32x2*)(trow + PT_ARR + ct * 16), pv = *(const LAS u32x2*)(trow + PT_ARR - PT_ROW + ct * 16); shift4(cu, pv, *(const f32x4*)(mu + 1024 + cl), kt);
                const f32x4 kkv = *(const f32x4*)(kk_ + cl);
#pragma unroll
                for (int j = 0; j < 4; ++j) { const float kr = kt[j] * kkv[j]; ssq += kr * kr; } }
            ssq += __shfl_xor(ssq, 16); ssq += __shfl_xor(ssq, 32);
            const float inv = __builtin_amdgcn_rsqf(fmaxf(ssq, 1e-24f));
            u32x4 fa, fr, fb, fk;
            unsigned char* fg = F.ws + WS_CFR + ((size_t)u * NH + hh) * 8192 + (size_t)lane * 16;
#pragma unroll
            for (int ct = 0; ct < 4; ++ct) {
                const int c0 = hh * 64 + ct * 16, cl = c0 + 4 * q + oz, wrow = c0 + tk + oz;
                f32x4 dd = {0, 0, 0, 0}, da = {0, 0, 0, 0}, dm = {0, 0, 0, 0};
#pragma unroll
                for (int ks = 0; ks < 2; ++ks) {
                    const bf16x8 ad = *(const bf16x8*)(WdecT + (size_t)wrow * 64 + ks * 32 + q * 8), aa = *(const bf16x8*)(WaaaT + (size_t)wrow * 64 + ks * 32 + q * 8);
                    dd = __builtin_amdgcn_mfma_f32_16x16x32_bf16(ad, Bw[ks], dd, 0, 0, 0);
                    da = __builtin_amdgcn_mfma_f32_16x16x32_bf16(aa, Ba[ks], da, 0, 0, 0);
                }
                if (l == 1) { const bf16x8 am = *(const bf16x8*)(WmvT + (size_t)wrow * 32 + q * 8); dm = __builtin_amdgcn_mfma_f32_16x16x32_bf16(am, Bm, dm, 0, 0, 0); }
                float rs[4], ks_[4], vs[4];
                { const u32x2 cu = *(const LAS u32x2*)(trow + ct * 16), pv = *(const LAS u32x2*)(trow - PT_ROW + ct * 16); shift4(cu, pv, *(const f32x4*)(mu + cl), rs); }
                { const u32x2 cu = *(const LAS u32x2*)(trow + PT_ARR + ct * 16), pv = *(const LAS u32x2*)(trow + PT_ARR - PT_ROW + ct * 16); shift4(cu, pv, *(const f32x4*)(mu + 1024 + cl), ks_); }
                { const u32x2 cu = *(const LAS u32x2*)(trow + 2 * PT_ARR + ct * 16), pv = *(const LAS u32x2*)(trow + 2 * PT_ARR - PT_ROW + ct * 16); shift4(cu, pv, *(const f32x4*)(mu + 2048 + cl), vs); }
                const f32x4 w0v = *(const f32x4*)(w0 + cl), a0v = *(const f32x4*)(a0 + cl), kkv = *(const f32x4*)(kk_ + cl), kav = *(const f32x4*)(ka_ + cl), rkv = *(const f32x4*)(rk_ + cl);
                if (l == 1) { const f32x4 mv0v = *(const f32x4*)(mv0 + cl); const f32x4 vf = *(const f32x4*)(vfirst + (size_t)m * RW + cl);
#pragma unroll
                    for (int j = 0; j < 4; ++j) vs[j] = vs[j] + (vf[j] - vs[j]) * sigm(mv0v[j] + dm[j]); }
                float At[4], Rt[4], Bh[4], Kh[4], pcv4[4];
#pragma unroll
                for (int j = 0; j < 4; ++j) {
                    const float lwv = -0.6065306597f * sigm(w0v[j] + dd[j]);
                    const float as = sigm(a0v[j] + da[j]);
                    const float kn = ks_[j] * kkv[j] * inv, av = -kn, bv = kn * as;
                    const float k2 = ks_[j] * (1.f + (as - 1.f) * kav[j]);
                    rks += rs[j] * k2 * rkv[j];
                    const float L = scan16(lwv);
                    const float e2 = __expf(L), e3 = __builtin_amdgcn_rcpf(e2);
                    const float e1 = __builtin_bit_cast(float, __builtin_amdgcn_update_dpp(0x3f800000, __builtin_bit_cast(int, e2), 0x111, 0xF, 0xF, false));
                    const float pcv = __builtin_bit_cast(float, __builtin_amdgcn_update_dpp(0, __builtin_bit_cast(int, e2), 0x15F, 0xF, 0xF, true));
                    const float e4 = pcv * e3;
                    At[j] = av * e1; Rt[j] = rs[j] * e2; Bh[j] = bv * e3; Kh[j] = k2 * e3; pcv4[j] = pcv;
                    const int idx = ((ct * 64 + (tk >> 2) * 16 + 4 * q + j) * 8 + (tk & 3)); bk[idx] = (bf16_t)cvtpk(bv * e4, 0.f); bk[idx + 4] = (bf16_t)cvtpk(k2 * e4, 0.f);
                }
                const f32x4 v4 = {vs[0], vs[1], vs[2], vs[3]};
                *(f32x4*)(sV + (size_t)m * RW + cl) = v4;
                if (tk == 0) *(f32x4*)(F.ws + WS_CPC + ((size_t)u * NH + hh) * 256 + (size_t)(16 * ct + 4 * q) * 4) = (f32x4){pcv4[0], pcv4[1], pcv4[2], pcv4[3]};
                if ((ct & 1) == 0) { fa.x = cvtpk(At[0], At[1]); fa.y = cvtpk(At[2], At[3]); fr.x = cvtpk(Rt[0], Rt[1]); fr.y = cvtpk(Rt[2], Rt[3]);
                                     fb.x = cvtpk(Bh[0], Bh[1]); fb.y = cvtpk(Bh[2], Bh[3]); fk.x = cvtpk(Kh[0], Kh[1]); fk.y = cvtpk(Kh[2], Kh[3]); }
                else               { fa.z = cvtpk(At[0], At[1]); fa.w = cvtpk(At[2], At[3]); fr.z = cvtpk(Rt[0], Rt[1]); fr.w = cvtpk(Rt[2], Rt[3]);
                                     fb.z = cvtpk(Bh[0], Bh[1]); fb.w = cvtpk(Bh[2], Bh[3]); fk.z = cvtpk(Kh[0], Kh[1]); fk.w = cvtpk(Kh[2], Kh[3]);
                                     const int ks2 = ct >> 1;
                                     *(u32x4*)(fg + ks2 * 1024) = fa; *(u32x4*)(fg + 2048 + ks2 * 1024) = fr; *(u32x4*)(fg + 4096 + ks2 * 1024) = fb; *(u32x4*)(fg + 6144 + ks2 * 1024) = fk; }
            }
            rks += __shfl_xor(rks, 16); rks += __shfl_xor(rks, 32);
            {
                const size_t pi = (size_t)u * NH + hh;
                LDS_WAIT();
#pragma unroll
                for (int kb = 0; kb < 4; ++kb) { const u32x4 val = *(const LAS u32x4*)(scr + (kb * 64 + lane) * 16); *(u32x4*)(F.ws + WS_CBK + pi * 4096 + (size_t)(kb * 64 + lane) * 16) = val; }
                LDS_WAIT();
            }
            if (q == 0) rk[(size_t)m * NH + hh] = rks;
        }
    }
    asm volatile("s_waitcnt vmcnt(0)" ::: "memory");
    for (int rep11 = 0; rep11 < NREP(11); ++rep11)
    for (int u = F.bid; u < M / 16; u += F.G) {
#pragma unroll 1
        for (int hh2 = 0; hh2 < 2; ++hh2) {
            int lane = F.lane; asm volatile("" : "+v"(lane));
            chunk_tail(F.lds + F.wave * PSCR, lane, F.ws, (size_t)u * NH + F.wave * 2 + hh2, sV + (size_t)(u * 16) * RW + (F.wave * 2 + hh2) * 64);
        }
    }
}

#define SQ_BAR() asm volatile("s_waitcnt lgkmcnt(0)\n\ts_barrier" ::: "memory")
constexpr int SQ_SLOT = 15 * 1024, SQ_RC = 4, SQ_BUF = SQ_RC * SQ_SLOT, SQ_NR = (SEQ / 16) / SQ_RC;
__device__ __forceinline__ void phase_scan(const Args& A, Ctx& F, int l) {
    F.refresh();
    (void)A; (void)l;
    float* o = (float*)(F.ws + WS_HM);
    const int lane = F.lane, wv = F.wave, q = lane >> 4;
    for (int u0 = F.bid; u0 < 256; u0 += F.G) {
        const int u = (F.G == 256) ? (((u0 & 7) * 8 + (u0 >> 5)) * 4 + ((u0 >> 3) & 3)) : u0;
        const int vs = u & 3, h = (u >> 2) & 15, b = u >> 6;
        const size_t pi0 = (size_t)(b * (SEQ / 16)) * NH + h;
        __syncthreads();
        if (wv >= 1 && wv <= 5) {
            const unsigned char* pb[3]; unsigned sb[3];
#pragma unroll
            for (int j = 0; j < 3; ++j) { const int id = 3 * (wv - 1) + j;
                if (id < 2)       { pb[j] = F.ws + WS_CW1 + pi0 * 2048 + (size_t)id * 1024 + lane * 16; sb[j] = 16 * 2048; }
                else if (id < 4)  { pb[j] = F.ws + WS_CR2 + pi0 * 2048 + (size_t)(id - 2) * 1024 + lane * 16; sb[j] = 16 * 2048; }
                else if (id < 8)  { pb[j] = F.ws + WS_CBK + pi0 * 4096 + (size_t)(id - 4) * 1024 + lane * 16; sb[j] = 16 * 4096; }
                else if (id < 12) { pb[j] = F.ws + WS_CPC + pi0 * 256 + (size_t)(16 * (id - 8) + 4 * q) * 4; sb[j] = 16 * 256; }
                else              { pb[j] = F.ws + (id == 12 ? WS_CU0 : (id == 13 ? WS_CY0 : WS_CVO)) + pi0 * 4096 + (size_t)vs * 1024 + lane * 16; sb[j] = 16 * 4096; } }
            u32x4 rs[3][SQ_RC][3];
#define SQ_LOAD(set, rnd) do { _Pragma("unroll") for (int i_ = 0; i_ < SQ_RC; ++i_) { int ch_ = (rnd) * SQ_RC + i_; ch_ = ch_ < SEQ / 16 ? ch_ : SEQ / 16 - 1; \
            _Pragma("unroll") for (int j_ = 0; j_ < 3; ++j_) rs[set][i_][j_] = *(const u32x4*)(pb[j_] + (size_t)ch_ * sb[j_]); } } while (0)
#define SQ_STORE(set, bufi) do { _Pragma("unroll") for (int i_ = 0; i_ < SQ_RC; ++i_) _Pragma("unroll") for (int j_ = 0; j_ < 3; ++j_) \
            *(LAS u32x4*)(F.lds + (bufi) * SQ_BUF + i_ * SQ_SLOT + (3 * (wv - 1) + j_) * 1024 + lane * 16) = rs[set][i_][j_]; } while (0)
            SQ_LOAD(0, 0); SQ_LOAD(1, 1); SQ_LOAD(2, 2);
            SQ_STORE(0, 0); SQ_LOAD(0, 3);
            SQ_BAR();
            for (int r0 = 0; r0 < SQ_NR + 1; r0 += 3) {
#pragma unroll
                for (int s3 = 0; s3 < 3; ++s3) { const int r = r0 + s3;
                    if (r < SQ_NR + 1) {
                        SQ_STORE((s3 + 1) % 3, (r + 1) & 1); SQ_LOAD((s3 + 1) % 3, r + 4);
                        SQ_BAR(); } }
            }
#undef SQ_LOAD
#undef SQ_STORE
        } else if (wv == 0) {
            f32x4 ST[4];
#pragma unroll
            for (int kb = 0; kb < 4; ++kb) ST[kb] = (f32x4){0.f, 0.f, 0.f, 0.f};
            float* orow = o + ((size_t)b * SEQ + 4 * q) * RW + h * 64 + vs * 16 + (lane & 15);
            SQ_BAR();
            for (int r = 0; r < SQ_NR + 1; ++r) {
                if (r < SQ_NR) {
                    bf16x8 W1[2][2], R2[2][2], BK[2][4]; f32x4 PC[2][4], U0[2], Y0[2], VO[2];
#define SQ_LDOPS(pp, ci) do { const LAS unsigned char* sl_ = F.lds + (r & 1) * SQ_BUF + (ci) * SQ_SLOT + lane * 16; \
                        _Pragma("unroll") for (int k2 = 0; k2 < 2; ++k2) { W1[pp][k2] = *(const LAS bf16x8*)(sl_ + k2 * 1024); R2[pp][k2] = *(const LAS bf16x8*)(sl_ + (2 + k2) * 1024); } \
                        _Pragma("unroll") for (int kb = 0; kb < 4; ++kb) { BK[pp][kb] = *(const LAS bf16x8*)(sl_ + (4 + kb) * 1024); PC[pp][kb] = *(const LAS f32x4*)(sl_ + (8 + kb) * 1024); } \
                        U0[pp] = *(const LAS f32x4*)(sl_ + 12 * 1024); Y0[pp] = *(const LAS f32x4*)(sl_ + 13 * 1024); VO[pp] = *(const LAS f32x4*)(sl_ + 14 * 1024); } while (0)
                    SQ_LDOPS(0, 0);
#pragma unroll
                    for (int i = 0; i < SQ_RC; ++i) {
                        const int pp = i & 1;
                        if (i + 1 < SQ_RC) SQ_LDOPS((i + 1) & 1, i + 1);
                        bf16x8 SB[2];
#pragma unroll
                        for (int k2 = 0; k2 < 2; ++k2) { u32x4 w; w.x = cvtpk(ST[2 * k2][0], ST[2 * k2][1]); w.y = cvtpk(ST[2 * k2][2], ST[2 * k2][3]);
                            w.z = cvtpk(ST[2 * k2 + 1][0], ST[2 * k2 + 1][1]); w.w = cvtpk(ST[2 * k2 + 1][2], ST[2 * k2 + 1][3]); SB[k2] = __builtin_bit_cast(bf16x8, w); }
                        f32x4 X = __builtin_amdgcn_mfma_f32_16x16x32_bf16(W1[pp][0], SB[0], U0[pp], 0, 0, 0); X = __builtin_amdgcn_mfma_f32_16x16x32_bf16(W1[pp][1], SB[1], X, 0, 0, 0);
                        f32x4 Yv = __builtin_amdgcn_mfma_f32_16x16x32_bf16(R2[pp][0], SB[0], Y0[pp], 0, 0, 0); Yv = __builtin_amdgcn_mfma_f32_16x16x32_bf16(R2[pp][1], SB[1], Yv, 0, 0, 0);
                        u32x4 uvw; uvw.x = cvtpk(X[0], X[1]); uvw.y = cvtpk(X[2], X[3]); uvw.z = cvtpk(VO[pp][0], VO[pp][1]); uvw.w = cvtpk(VO[pp][2], VO[pp][3]);
                        const bf16x8 UV = __builtin_bit_cast(bf16x8, uvw);
#pragma unroll
                        for (int kb = 0; kb < 4; ++kb) ST[kb] = __builtin_amdgcn_mfma_f32_16x16x32_bf16(BK[pp][kb], UV, ST[kb] * PC[pp][kb], 0, 0, 0);
                        float* op = orow + (size_t)((r * SQ_RC + i) * 16) * RW;
#pragma unroll
                        for (int j = 0; j < 4; ++j) op[(size_t)j * RW] = Yv[j];
                    }
#undef SQ_LDOPS
                }
                SQ_BAR();
            }
        } else {
            SQ_BAR();
            for (int r = 0; r < SQ_NR + 1; ++r) SQ_BAR();
        }
    }
    __syncthreads();
}

__device__ __forceinline__ void phase_post(const Args& A, Ctx& F, int l) {
    F.refresh();
    const int gw = F.bid * NWAVES + F.wave, NGW = F.G * NWAVES, lane = F.lane;
    const float* o = (const float*)(F.ws + WS_HM); const float* sV = (const float*)(F.ws + (l == 0 ? WS_V0 : WS_V1)); const float* rk = (const float*)(F.ws + WS_RK);
    const bf16_t* proj = (const bf16_t*)(F.ws + WS_PROJ); bf16_t* yb = (bf16_t*)(F.ws + WS_YB);
    const float* lg = A.in[20] + l * RW + 16 * lane; const float* lb = A.in[21] + l * RW + 16 * lane; const float* mu = A.in[8] + (size_t)l * 4224 + 3072 + 16 * lane;
    f32x4 g4[4], b4[4], mu4[4];
#pragma unroll
    for (int j = 0; j < 4; ++j) { g4[j] = *(const f32x4*)(lg + 4 * j); b4[j] = *(const f32x4*)(lb + 4 * j); mu4[j] = *(const f32x4*)(mu + 4 * j); }
    const u32x4 zero4 = {0u, 0u, 0u, 0u};
    f32x4 on[4], vn[4]; u32x4 cn[2], pn[2]; float rkn = 0.f;
#define POST_LOAD(mm) do { const bool hp_ = ((mm) & (SEQ - 1)) != 0; const bf16_t* pr_ = proj + (size_t)(mm) * NPAD + C_ZB + 16 * lane; \
        _Pragma("unroll") for (int j = 0; j < 4; ++j) { on[j] = *(const f32x4*)(o + (size_t)(mm) * RW + 16 * lane + 4 * j); vn[j] = *(const f32x4*)(sV + (size_t)(mm) * RW + 16 * lane + 4 * j); } \
        _Pragma("unroll") for (int hf = 0; hf < 2; ++hf) { cn[hf] = *(const u32x4*)(pr_ + 8 * hf); pn[hf] = hp_ ? *(const u32x4*)(pr_ - NPAD + 8 * hf) : zero4; } \
        rkn = rk[(size_t)(mm) * NH + (lane >> 2)]; } while (0)
    if (gw < M) POST_LOAD(gw);
    for (int m = gw; m < M; m += NGW) {
        f32x4 ov[4], vv[4]; u32x4 cu[2], pv[2];
#pragma unroll
        for (int j = 0; j < 4; ++j) { ov[j] = on[j]; vv[j] = vn[j]; }
        cu[0] = cn[0]; cu[1] = cn[1]; pv[0] = pn[0]; pv[1] = pn[1]; const float rkv = rkn;
        if (m + NGW < M) POST_LOAD(m + NGW);
        float s = 0.f;
#pragma unroll
        for (int j = 0; j < 4; ++j) s += (ov[j][0] + ov[j][1]) + (ov[j][2] + ov[j][3]);
        s += __shfl_xor(s, 1); s += __shfl_xor(s, 2);
        const float mean = s * (1.f / 64.f); float s2 = 0.f;
#pragma unroll
        for (int j = 0; j < 4; ++j) { ov[j] = ov[j] - mean; s2 += (ov[j][0] * ov[j][0] + ov[j][1] * ov[j][1]) + (ov[j][2] * ov[j][2] + ov[j][3] * ov[j][3]); }
        s2 += __shfl_xor(s2, 1); s2 += __shfl_xor(s2, 2);
        const float rstd = rsqrtf(s2 * (1.f / 64.f) + LNX_EPS);
#pragma unroll
        for (int hf = 0; hf < 2; ++hf) {
            float zs[8], mul[8];
#pragma unroll
            for (int i = 0; i < 4; ++i) { mul[i] = mu4[2 * hf][i]; mul[4 + i] = mu4[2 * hf + 1][i]; }
            shift8(cu[hf], pv[hf], mul, zs);
            float y[8];
#pragma unroll
            for (int jj = 0; jj < 2; ++jj) { const int j = 2 * hf + jj;
#pragma unroll
                for (int i = 0; i < 4; ++i) y[4 * jj + i] = (ov[j][i] * rstd * g4[j][i] + b4[j][i] + rkv * vv[j][i]) * silu(zs[4 * jj + i]); }
            u32x4 w; w.x = cvtpk(y[0], y[1]); w.y = cvtpk(y[2], y[3]); w.z = cvtpk(y[4], y[5]); w.w = cvtpk(y[6], y[7]);
            *(u32x4*)(yb + (size_t)m * RW + 16 * lane + 8 * hf) = w;
        }
    }
#undef POST_LOAD
}


#define XB_TMO      128
#define XB_XCNT(j)  (256  + 64 * (j))
#define XB_XSUB(j)  (1280 + 64 * (j))
#define XB_XGEN(j)  (2304 + 64 * (j))
#define XB_TOP      3328
#define XB_TOPGEN   3392
#define XCD_BAR_WORDS 3456
#define XB_SPIN_CAP (1u << 20)
__device__ __forceinline__ unsigned xb_ld(unsigned* p)              { return __hip_atomic_load(p, __ATOMIC_RELAXED, __HIP_MEMORY_SCOPE_AGENT); }
__device__ __forceinline__ unsigned xb_add(unsigned* p, unsigned v) { return __hip_atomic_fetch_add(p, v, __ATOMIC_RELAXED, __HIP_MEMORY_SCOPE_AGENT); }
__device__ __forceinline__ unsigned xb_xcc_id() { return (unsigned)__builtin_amdgcn_s_getreg((3 << 11) | 20) & 0xFu; }
#define XB_SPIN(cond, bar) do { unsigned _sp = 0; while (cond) { __builtin_amdgcn_s_sleep(1); \
    if ((++_sp & 255u) == 0u) { if (xb_ld(&(bar)[XB_TMO])) break; if (_sp > XB_SPIN_CAP) { atomicAdd(&(bar)[XB_TMO], 1u); break; } } } } while (0)
struct XcdBarrier { unsigned* bar; unsigned x; volatile LAS unsigned* st; };
__device__ __forceinline__ XcdBarrier xcd_barrier_post(unsigned* bar, volatile LAS unsigned* st) {
    XcdBarrier b; b.bar = bar; b.x = xb_xcc_id(); b.st = st;
    if (threadIdx.x == 0) (void)xb_add(&bar[XB_XCNT(b.x)], 1u);
    return b;
}
__device__ __forceinline__ void xcd_barrier_complete(unsigned* bar, unsigned x, unsigned& nloc, unsigned& nx) {
    const unsigned G = gridDim.x * gridDim.y * gridDim.z;
    unsigned sum, cnt, mine, sp = 0u;
    for (;;) {
        sum = 0u; cnt = 0u; mine = 0u;
#pragma unroll
        for (unsigned j = 0; j < 16; ++j) { const unsigned c = xb_ld(&bar[XB_XCNT(j)]); sum += c; cnt += (c > 0u) ? 1u : 0u; mine = (j == x) ? c : mine; }
        if (sum == G) break;
        __builtin_amdgcn_s_sleep(1);
        if ((++sp & 255u) == 0u) { if (xb_ld(&bar[XB_TMO])) break; if (sp > XB_SPIN_CAP) { atomicAdd(&bar[XB_TMO], 1u); break; } }
    }
    nloc = mine > 0u ? mine : 1u; nx = cnt > 0u ? cnt : 1u;
}
__device__ __forceinline__ void xcd_barrier(const XcdBarrier& b) {
    asm volatile("s_waitcnt vmcnt(0)" ::: "memory");
    __syncthreads();
    if (threadIdx.x == 0) {
        unsigned* bar = b.bar;
        __builtin_amdgcn_s_waitcnt(0);
        unsigned nloc = b.st[0], nx = b.st[1];
        if (nloc == 0u) { xcd_barrier_complete(bar, b.x, nloc, nx); b.st[0] = nloc; b.st[1] = nx; }
        const unsigned old = xb_add(&bar[XB_XSUB(b.x)], 1u);
        const unsigned gen = old / nloc;
        if (old + 1u == (gen + 1u) * nloc) {
            __builtin_amdgcn_fence(__ATOMIC_RELEASE, "agent");
            asm volatile("s_waitcnt vmcnt(0)" ::: "memory");
            const unsigned og = xb_add(&bar[XB_TOP], 1u);
            const unsigned tg = og / nx;
            if (og + 1u == (tg + 1u) * nx) xb_add(&bar[XB_TOPGEN], 1u);
            else XB_SPIN(xb_ld(&bar[XB_TOPGEN]) == tg, bar);
            __builtin_amdgcn_fence(__ATOMIC_ACQUIRE, "agent");
            xb_add(&bar[XB_XGEN(b.x)], 1u);
            asm volatile("s_waitcnt vmcnt(0)" ::: "memory");
        } else {
            XB_SPIN(xb_ld(&bar[XB_XGEN(b.x)]) == gen, bar);
            __builtin_amdgcn_fence(__ATOMIC_ACQUIRE, "agent");
            asm volatile("s_waitcnt vmcnt(0)" ::: "memory");
        }
    }
    __syncthreads();
}
constexpr size_t WS_BAR = 512 * 1024;
constexpr int LDS_ST = 8 * PSCR + 64;

__global__ void __launch_bounds__(NTHREADS, 2) mk_fwd(Args args) {
    extern __shared__ __attribute__((aligned(16))) unsigned char lds_raw[];
    Ctx F;
    F.lds = (LAS unsigned char*)lds_raw;
    F.tid = threadIdx.x; F.lane = F.tid & 63; F.wave = __builtin_amdgcn_readfirstlane(F.tid >> 6);
    F.G = gridDim.x; F.bid = blockIdx.x;
    F.out = args.out; F.ws = args.ws;
    const int lo = args.ph_lo, hi = args.ph_hi;
#if MK_COOP
    cg::grid_group grid = cg::this_grid();
    unsigned* barw = (unsigned*)(F.ws + WS_CTL + WS_BAR);
    volatile LAS unsigned* st = (volatile LAS unsigned*)(F.lds + LDS_ST);
    if (F.tid < 2) st[F.tid] = 0u;
    if (F.bid == 0) for (int i = F.tid; i < XCD_BAR_WORDS; i += NTHREADS) __hip_atomic_store(barw + i, 0u, __ATOMIC_RELAXED, __HIP_MEMORY_SCOPE_AGENT);
    __syncthreads();
    XcdBarrier xbar; xbar.bar = barw; xbar.x = 0; xbar.st = st;
#define SEAM(k) do { if (lo <= (k) && (k) + 1 < hi) { if ((k) == 0) { grid.sync(); xbar = xcd_barrier_post(barw, st); } else xcd_barrier(xbar); } } while (0)
#else
#define SEAM(k) do { } while (0)
#endif
#ifndef PHMASK
#define PHMASK 0xFFFF
#endif
#define IN(k) (lo <= (k) && (k) < hi)
#define PM(i) ((PHMASK >> (i)) & 1)

    bf16_t* WinT = (bf16_t*)(F.ws + WS_WINT);
    bf16_t* hbuf = (bf16_t*)(F.ws + WS_HM);
    bf16_t* proj = (bf16_t*)(F.ws + WS_PROJ);

    if (PM(0) && IN(0)) { for (int rep = 0; rep < NREP(0); ++rep) phase_convert(args, F); SEAM(0); }
    if (PM(1) && IN(1)) {
        for (int rep = 0; rep < NREP(1); ++rep)
        {
            const int gi = F.bid >> 3; const bool valid = F.bid < 64; const int l = gi >> 2, g = gi & 3;
            pg8::Gemm gm{(const bf16_t*)(F.ws + WS_WPOOLT) + (size_t)(valid ? gi : 0) * 65536, (const bf16_t*)(F.ws + WS_WINUA) + (size_t)(valid ? gi : 0) * DM * 256, 256, DM, 256};
            pg8::OneUnit S{valid, {0, F.bid & 7}};
            pg8::EpiBf16 E{WinT + (size_t)(valid ? l : 0) * NPAD * DM + (size_t)(valid ? g : 0) * 256 * DM, DM};
            pg8::gemm_phase<pg8::EpiBf16, pg8::OneUnit, true, true>(F.lds, gm, S, E);
        }
        if (F.G == 256) {
            if (F.bid >= 64) phase_rows(args, F, 0, (F.bid - 64) * NWAVES + F.wave, 1536, 5);
            else phase_rows(args, F, 0, 7680 + F.bid * NWAVES + F.wave, 1, 1);
        } else phase_rows(args, F, 0);
        SEAM(1);
    }
#pragma unroll 1
    for (int l = 0; l < 2; ++l) {
        const int pb = 2 + 7 * l;
        if (PM(2) && IN(pb + 0)) {
            for (int rep = 0; rep < NREP(2); ++rep) {
            pg8::Gemm gm{hbuf, WinT + (size_t)l * NPAD * DM, M, NPAD, DM}; pg8::StaticOrder S; S.init(M, NPAD, F.G, F.bid);
            pg8::EpiBf16 E{proj, NPAD};
            pg8::gemm_phase<pg8::EpiBf16, pg8::StaticOrder, true, true>(F.lds, gm, S, E); }
            SEAM(pb + 0);
        }
        if (PM(3) && IN(pb + 1)) { for (int rep = 0; rep < NREP(3); ++rep) phase_prep(args, F, l); SEAM(pb + 1); }
        if (PM(4) && IN(pb + 2)) { for (int rep = 0; rep < NREP(4); ++rep) phase_scan(args, F, l); SEAM(pb + 2); }
        if (PM(5) && IN(pb + 3)) { for (int rep = 0; rep < NREP(5); ++rep) phase_post(args, F, l); SEAM(pb + 3); }
        if (PM(6) && IN(pb + 4)) {
            for (int rep = 0; rep < NREP(6); ++rep) {
            pg8::StaticOrder S; S.init(M, DM, F.G, F.bid);
            { pg8::Gemm gm{(const bf16_t*)(F.ws + WS_YA), (const bf16_t*)(F.ws + WS_WBRA) + (size_t)l * DM * PW, M, DM, PW};
              pg8::EpiGate<false> E{hbuf, DM, proj, NPAD, C_GA};
              pg8::gemm_phase<pg8::EpiGate<false>, pg8::StaticOrder, true, true>(F.lds, gm, S, E); }
            { pg8::Gemm gm{(const bf16_t*)(F.ws + WS_YB), (const bf16_t*)(F.ws + WS_WBRB) + (size_t)l * DM * RW, M, DM, RW};
              pg8::EpiGate<true> E{hbuf, DM, proj, NPAD, C_GB};
              pg8::gemm_phase<pg8::EpiGate<true>, pg8::StaticOrder, true, true>(F.lds, gm, S, E); } }
            SEAM(pb + 4);
        }
        if (PM(7) && IN(pb + 5)) {
            for (int rep = 0; rep < NREP(7); ++rep) {
            pg8::Gemm gm{hbuf, (const bf16_t*)(F.ws + WS_WOUT) + (size_t)l * DM * DM, M, DM, DM}; pg8::StaticOrder S; S.init(M, DM, F.G, F.bid);
            pg8::EpiBf16 E{(bf16_t*)(F.ws + WS_OUTF), DM};
            pg8::gemm_phase<pg8::EpiBf16, pg8::StaticOrder, true, true>(F.lds, gm, S, E); }
            SEAM(pb + 5);
        }
        if (PM(8) && IN(pb + 6)) { phase_rows(args, F, l + 1); SEAM(pb + 6); }
    }
#undef IN
#undef SEAM
}

extern "C" void kernel_launch(void* const* d_in, const int* in_sizes, int n_in, void* d_out, int out_size, void* d_ws, size_t ws_size, hipStream_t stream) {
    static int grid = 0;
    if (grid == 0) {
        if (n_in != 26 || out_size != M * DM || ws_size < WS_END) { fprintf(stderr, "kernel_launch: unexpected shapes (n_in %d, out %d, ws %zu < %zu)\n", n_in, out_size, ws_size, (size_t)WS_END); grid = -1; return; }
        int dev = 0, cus = 0, per_cu = 0;
        if (hipGetDevice(&dev) != hipSuccess || hipDeviceGetAttribute(&cus, hipDeviceAttributeMultiprocessorCount, dev) != hipSuccess) { grid = -1; return; }
        if (hipFuncSetAttribute((const void*)mk_fwd, hipFuncAttributeMaxDynamicSharedMemorySize, LDS_BYTES) != hipSuccess) { fprintf(stderr, "kernel_launch: hipFuncSetAttribute failed\n"); grid = -1; return; }
        if (hipOccupancyMaxActiveBlocksPerMultiprocessor(&per_cu, (const void*)mk_fwd, NTHREADS, LDS_BYTES) != hipSuccess || per_cu < 1) { fprintf(stderr, "kernel_launch: occupancy query gave %d\n", per_cu); (void)hipGetLastError(); per_cu = 1; }
        grid = cus * per_cu;
        if (grid > 256) grid = 256;
    }
    if (grid < 0) return;
    Args a{};
    for (int i = 0; i < 26; ++i) a.in[i] = (const float*)d_in[i];
    a.out = (float*)d_out; a.ws = (unsigned char*)d_ws;
#if MK_COOP
    a.ph_lo = 0; a.ph_hi = NPHASES;
    void* kargs[] = {&a};
    hipError_t e = hipLaunchCooperativeKernel((const void*)mk_fwd, dim3(grid), dim3(NTHREADS), kargs, LDS_BYTES, stream);
    if (e != hipSuccess) fprintf(stderr, "cooperative launch failed: %s (grid %d)\n", hipGetErrorString(e), grid);
#else
    for (int p = 0; p < NPHASES; ++p) {
        a.ph_lo = p; a.ph_hi = p + 1;
        hipLaunchKernelGGL(mk_fwd, dim3(grid), dim3(NTHREADS), LDS_BYTES, stream, a);
    }
#endif
}
```
